# Optimizing an MI355X kernel written in HIP

```python
import math
import jax, jax.numpy as jnp
from jax import lax
import numpy as np

D_MODEL = 1024
BATCH = 2
SEQ = 8192
DEPTH = 2
DEC_BATCH = 32
DEC_SEQ = 8
PAST_LEN = 16384
PAGE_SIZE = 128

D_MIX = D_MODEL
D_ATT = D_MIX // 2
N_HEADS = 8
HEAD_DIM = D_ATT // N_HEADS
DILATED_GROUPS = ((128, 1), (512, 4), (2048, 16))
ATT_WINDOW = max(w for w, _ in DILATED_GROUPS)
ATT_BLOCK = 128
D_SSM = D_MIX // 4
SSM_GROUP = 16
N_SSM_GROUPS = D_SSM // SSM_GROUP
SSM_STATE = 64
DT_MIN = 1e-3
DT_MAX = 1e-1
D_POOL = D_MIX // 4
POOL_WINDOWS = (2, 4, 8, 16)
N_POOL_GROUPS = len(POOL_WINDOWS)
POOL_GROUP = D_POOL // N_POOL_GROUPS
POOL_BUF = max(POOL_WINDOWS) - 1
D_IN = 3 * D_ATT + D_SSM + D_POOL
D_FF = 2816
CONV_WIDTH = 3
CONV_BUF = CONV_WIDTH - 1
EPS = 1e-6
NEG = -1e30

kernel_name = 'hybrid_dilated_s5_pool_decoder_step'


def _rmsnorm(x, g):
    xf = x.astype(jnp.float32)
    return xf * lax.rsqrt(jnp.mean(xf * xf, axis=-1, keepdims=True) + EPS) * g.astype(jnp.float32)


def _dilated_prompt(q, k, v, window, dilation):
    b, s, h, e = q.shape
    n_back = window // dilation
    blk = ATT_BLOCK
    span = dilation * blk
    s_pad = -(-s // span) * span
    nb = s_pad // span
    pad = ((0, 0), (0, s_pad - s), (0, 0), (0, 0))

    def blocks(t):
        return jnp.pad(t, pad).reshape(b, nb, blk, dilation, h, e)

    def with_prev(t):
        prev = jnp.concatenate([jnp.zeros_like(t[:, :1]), t[:, :-1]], axis=1)
        return jnp.concatenate([prev, t], axis=2)

    qb = blocks(q)
    kc = with_prev(blocks(k))
    vc = with_prev(blocks(v))
    sc = jnp.einsum('bnqrhe,bnkrhe->bnrhqk', qb, kc) * (e ** -0.5)
    qi = jnp.arange(blk)[:, None] + blk
    ki = jnp.arange(2 * blk)[None, :]
    rel = qi - ki
    band = (rel >= 0) & (rel <= n_back)
    has_prev = (jnp.arange(nb)[:, None, None] > 0) | (ki[None] >= blk)
    mask = band[None] & has_prev
    sc = jnp.where(mask[None, :, None, None], sc, NEG)
    m = jnp.max(sc, axis=-1, keepdims=True)
    p = jnp.exp(sc - m)
    l = jnp.sum(p, axis=-1)
    o = jnp.einsum('bnrhqk,bnkrhe->bnqrhe', p, vc) / jnp.transpose(l, (0, 1, 4, 2, 3))[..., None]
    lse = jnp.transpose(m[..., 0] + jnp.log(l), (0, 1, 4, 2, 3))
    return o.reshape(b, s_pad, h, e)[:, :s], lse.reshape(b, s_pad, h)[:, :s]


def _dilated_decode(q, k_all, v_all, n_past, window, dilation):
    t = q.shape[1]
    n_back = window // dilation
    idx = n_past + jnp.arange(t)[:, None] - dilation * jnp.arange(n_back + 1)[None, :]
    valid = idx >= 0
    idx = jnp.maximum(idx, 0)
    kg = k_all[:, idx]
    vg = v_all[:, idx]
    sc = jnp.einsum('bthe,btnhe->bhtn', q, kg) * (q.shape[-1] ** -0.5)
    sc = jnp.where(valid[None, None], sc, NEG)
    m = jnp.max(sc, axis=-1, keepdims=True)
    p = jnp.exp(sc - m)
    l = jnp.sum(p, axis=-1)
    o = jnp.einsum('bhtn,btnhe->bthe', p, vg) / jnp.transpose(l, (0, 2, 1))[..., None]
    lse = jnp.transpose(m[..., 0] + jnp.log(l), (0, 2, 1))
    return o, lse


def _merge_by_denominator(outs, lses):
    w = jax.nn.softmax(jnp.stack(lses, 0), axis=0)
    return jnp.einsum('gbth,gbthe->bthe', w, jnp.stack(outs, 0))


def _cplx_affine_op(e1, e2):
    a1r, a1i, b1r, b1i = e1
    a2r, a2i, b2r, b2i = e2
    return (a2r * a1r - a2i * a1i,
            a2r * a1i + a2i * a1r,
            a2r * b1r - a2i * b1i + b2r,
            a2r * b1i + a2i * b1r + b2i)


def _s5(u, h0_re, h0_im, log_dt, a_re, a_im, b_re, b_im, c_re, c_im, d_skip, w_glu, b_glu):
    f32 = jnp.float32
    bsz, t, _ = u.shape
    a_re = a_re.astype(f32)
    a_im = a_im.astype(f32)
    dt = jnp.exp(log_dt.astype(f32))[:, None]
    mag = jnp.exp(dt * a_re)
    ab_re = mag * jnp.cos(dt * a_im)
    ab_im = mag * jnp.sin(dt * a_im)
    den = a_re * a_re + a_im * a_im
    n_re = ab_re - 1.0
    n_im = ab_im
    co_re = (n_re * a_re + n_im * a_im) / den
    co_im = (n_im * a_re - n_re * a_im) / den
    b_re = b_re.astype(f32)
    b_im = b_im.astype(f32)
    bb_re = co_re[..., None] * b_re - co_im[..., None] * b_im
    bb_im = co_re[..., None] * b_im + co_im[..., None] * b_re
    ug = u.reshape(bsz, t, N_SSM_GROUPS, SSM_GROUP)
    bu_re = jnp.einsum('btgc,gpc->btgp', ug, bb_re)
    bu_im = jnp.einsum('btgc,gpc->btgp', ug, bb_im)
    h0_re = h0_re.astype(f32)
    h0_im = h0_im.astype(f32)
    bu_re = bu_re.at[:, 0].add(ab_re * h0_re - ab_im * h0_im)
    bu_im = bu_im.at[:, 0].add(ab_re * h0_im + ab_im * h0_re)
    shape = bu_re.shape
    elems = (jnp.broadcast_to(ab_re, shape), jnp.broadcast_to(ab_im, shape), bu_re, bu_im)
    _, _, h_re, h_im = lax.associative_scan(_cplx_affine_op, elems, axis=1)
    y = (jnp.einsum('btgp,gcp->btgc', h_re, c_re.astype(f32))
         - jnp.einsum('btgp,gcp->btgc', h_im, c_im.astype(f32))).reshape(bsz, t, D_SSM)
    y = y + d_skip.astype(f32) * u
    g = jax.nn.gelu(y)
    out = g * jax.nn.sigmoid(g @ w_glu.astype(f32) + b_glu.astype(f32))
    return out, h_re[:, -1], h_im[:, -1]


def _pool_mix(u, prefix, start_pos, pool_w, pool_scale):
    f32 = jnp.float32
    b, t, _ = u.shape
    uc = jnp.concatenate([prefix.astype(f32), u.astype(f32)], axis=1)
    cs = jnp.concatenate([jnp.zeros((b, 1, D_POOL), f32), jnp.cumsum(uc, axis=1)], axis=1)
    end = cs[:, POOL_BUF + 1:]
    pos = start_pos + jnp.arange(t)
    cur = uc[:, POOL_BUF:]
    outs = []
    for gi, w in enumerate(POOL_WINDOWS):
        sl = slice(gi * POOL_GROUP, (gi + 1) * POOL_GROUP)
        win_sum = end[..., sl] - cs[:, POOL_BUF + 1 - w:POOL_BUF + 1 - w + t, sl]
        cnt = jnp.minimum(pos + 1, w).astype(f32)[None, :, None]
        outs.append(win_sum / cnt - cur[..., sl])
    pooled = jnp.stack(outs, axis=2)
    mixed = jnp.einsum('btgc,gcd->btgd', pooled, pool_w.astype(f32)).reshape(b, t, D_POOL)
    return mixed * pool_scale.astype(f32), uc[:, -POOL_BUF:]


def _causal_dwconv(h, prefix, w, bias):
    t = h.shape[1]
    hc = jnp.concatenate([prefix.astype(h.dtype), h], axis=1)
    w = w.astype(h.dtype)
    y = bias.astype(h.dtype) + hc[:, 0:t] * w[0]
    for j in range(1, CONV_WIDTH):
        y = y + hc[:, j:j + t] * w[j]
    return y, hc[:, -CONV_BUF:]


def _layer(x, lw, k_past, v_past, h0_re, h0_im, pool_prefix, conv_prefix, start_pos, prompt):
    f32 = jnp.float32
    b, t, _ = x.shape
    hn = _rmsnorm(x, lw['norm1_g'])
    z = hn @ lw['w_in'].astype(f32)
    q, k, v, u_ssm, u_pool = jnp.split(z, [D_ATT, 2 * D_ATT, 3 * D_ATT, 3 * D_ATT + D_SSM], axis=-1)
    q = q.reshape(b, t, N_HEADS, HEAD_DIM)
    k = k.reshape(b, t, N_HEADS, HEAD_DIM)
    v = v.reshape(b, t, N_HEADS, HEAD_DIM)
    outs, lses = [], []
    if prompt:
        for (w, d) in DILATED_GROUPS:
            o, l = _dilated_prompt(q, k, v, w, d)
            outs.append(o)
            lses.append(l)
        n_keep = min(ATT_WINDOW, t)
        k_new, v_new = k[:, t - n_keep:], v[:, t - n_keep:]
    else:
        n_past = k_past.shape[1]
        k_all = jnp.concatenate([k_past.astype(f32), k], axis=1)
        v_all = jnp.concatenate([v_past.astype(f32), v], axis=1)
        for (w, d) in DILATED_GROUPS:
            o, l = _dilated_decode(q, k_all, v_all, n_past, w, d)
            outs.append(o)
            lses.append(l)
        k_new, v_new = k, v
    att = _merge_by_denominator(outs, lses).reshape(b, t, D_ATT)
    ssm_out, h_re, h_im = _s5(u_ssm, h0_re, h0_im, lw['ssm_log_dt'], lw['ssm_a_re'], lw['ssm_a_im'],
                              lw['ssm_b_re'], lw['ssm_b_im'], lw['ssm_c_re'], lw['ssm_c_im'],
                              lw['ssm_d'], lw['ssm_w_glu'], lw['ssm_b_glu'])
    pool_out, pool_state = _pool_mix(u_pool, pool_prefix, start_pos, lw['pool_w'], lw['pool_scale'])
    mix = jnp.concatenate([_rmsnorm(att, lw['out_norm_att']),
                           _rmsnorm(ssm_out, lw['out_norm_ssm']),
                           _rmsnorm(pool_out, lw['out_norm_pool'])], axis=-1)
    x = x.astype(f32) + mix @ lw['w_out'].astype(f32)
    hn2 = _rmsnorm(x, lw['norm2_g'])
    up = hn2 @ lw['w_up'].astype(f32)
    up_c, conv_state = _causal_dwconv(up, conv_prefix, lw['conv_w'], lw['conv_b'])
    a, g = jnp.split(up_c, 2, axis=-1)
    x = x + (jax.nn.silu(g) * a) @ lw['w_down'].astype(f32)
    return x, (k_new, v_new, h_re, h_im, pool_state, conv_state)


def _normal(k, shape, scale):
    return scale * jax.random.normal(k, shape, jnp.float32)


def setup_inputs(seed: int = 0) -> dict:
    key = jax.random.key(seed)
    ks = jax.random.split(key, 32)
    att_buf = min(ATT_WINDOW, PAST_LEN)
    x_prompt = _normal(ks[0], (BATCH, SEQ, D_MODEL), 1.0)
    x_sample = _normal(ks[1], (DEC_BATCH, DEC_SEQ, D_MODEL), 1.0)
    cache_k = _normal(ks[2], (DEPTH, DEC_BATCH, att_buf, N_HEADS, HEAD_DIM), 1.0)
    cache_v = _normal(ks[3], (DEPTH, DEC_BATCH, att_buf, N_HEADS, HEAD_DIM), 1.0)
    state_ssm_re = _normal(ks[4], (DEPTH, DEC_BATCH, N_SSM_GROUPS, SSM_STATE), 0.1)
    state_ssm_im = _normal(ks[5], (DEPTH, DEC_BATCH, N_SSM_GROUPS, SSM_STATE), 0.1)
    state_pool = _normal(ks[6], (DEPTH, DEC_BATCH, POOL_BUF, D_POOL), 1.0)
    state_conv = _normal(ks[7], (DEPTH, DEC_BATCH, CONV_BUF, 2 * D_FF), 1.0)
    norm1_g = 1.0 + _normal(ks[8], (DEPTH, D_MODEL), 0.02)
    w_in = _normal(ks[9], (DEPTH, D_MODEL, D_IN), D_MODEL ** -0.5)
    ssm_log_dt = jax.random.uniform(ks[10], (DEPTH, N_SSM_GROUPS), jnp.float32,
                                    math.log(DT_MIN), math.log(DT_MAX))
    ssm_a_re = -0.5 + _normal(ks[11], (DEPTH, N_SSM_GROUPS, SSM_STATE), 0.01)
    ssm_a_im = (math.pi * jnp.arange(SSM_STATE, dtype=jnp.float32)
                + _normal(ks[12], (DEPTH, N_SSM_GROUPS, SSM_STATE), 0.01))
    ssm_b_re = _normal(ks[13], (DEPTH, N_SSM_GROUPS, SSM_STATE, SSM_GROUP), (2 * SSM_GROUP) ** -0.5)
    ssm_b_im = _normal(ks[14], (DEPTH, N_SSM_GROUPS, SSM_STATE, SSM_GROUP), (2 * SSM_GROUP) ** -0.5)
    ssm_c_re = _normal(ks[15], (DEPTH, N_SSM_GROUPS, SSM_GROUP, SSM_STATE), SSM_STATE ** -0.5)
    ssm_c_im = _normal(ks[16], (DEPTH, N_SSM_GROUPS, SSM_GROUP, SSM_STATE), SSM_STATE ** -0.5)
    ssm_d = _normal(ks[17], (DEPTH, D_SSM), 1.0)
    ssm_w_glu = _normal(ks[18], (DEPTH, D_SSM, D_SSM), D_SSM ** -0.5)
    ssm_b_glu = _normal(ks[19], (DEPTH, D_SSM), 0.02)
    pool_w = _normal(ks[20], (DEPTH, N_POOL_GROUPS, POOL_GROUP, POOL_GROUP), POOL_GROUP ** -0.5)
    pool_scale = 1.0 + _normal(ks[21], (DEPTH, D_POOL), 0.1)
    out_norm_att = 1.0 + _normal(ks[22], (DEPTH, D_ATT), 0.02)
    out_norm_ssm = 1.0 + _normal(ks[23], (DEPTH, D_SSM), 0.02)
    out_norm_pool = 1.0 + _normal(ks[24], (DEPTH, D_POOL), 0.02)
    w_out = _normal(ks[25], (DEPTH, D_MIX, D_MODEL), D_MIX ** -0.5)
    norm2_g = 1.0 + _normal(ks[26], (DEPTH, D_MODEL), 0.02)
    w_up = _normal(ks[27], (DEPTH, D_MODEL, 2 * D_FF), D_MODEL ** -0.5)
    conv_w = _normal(ks[28], (DEPTH, CONV_WIDTH, 2 * D_FF), CONV_WIDTH ** -0.5)
    conv_b = _normal(ks[29], (DEPTH, 2 * D_FF), 0.02)
    w_down = _normal(ks[30], (DEPTH, D_FF, D_MODEL), D_FF ** -0.5)
    norm_f_g = 1.0 + _normal(ks[31], (D_MODEL,), 0.02)
    return {'x_prompt': x_prompt, 'x_sample': x_sample, 'cache_k': cache_k, 'cache_v': cache_v,
            'state_ssm_re': state_ssm_re, 'state_ssm_im': state_ssm_im, 'state_pool': state_pool,
            'state_conv': state_conv, 'norm1_g': norm1_g, 'w_in': w_in, 'ssm_log_dt': ssm_log_dt,
            'ssm_a_re': ssm_a_re, 'ssm_a_im': ssm_a_im, 'ssm_b_re': ssm_b_re, 'ssm_b_im': ssm_b_im,
            'ssm_c_re': ssm_c_re, 'ssm_c_im': ssm_c_im, 'ssm_d': ssm_d, 'ssm_w_glu': ssm_w_glu,
            'ssm_b_glu': ssm_b_glu, 'pool_w': pool_w, 'pool_scale': pool_scale,
            'out_norm_att': out_norm_att, 'out_norm_ssm': out_norm_ssm, 'out_norm_pool': out_norm_pool,
            'w_out': w_out, 'norm2_g': norm2_g, 'w_up': w_up, 'conv_w': conv_w, 'conv_b': conv_b,
            'w_down': w_down, 'norm_f_g': norm_f_g}


def reference(x_prompt, x_sample, cache_k, cache_v, state_ssm_re, state_ssm_im, state_pool, state_conv,
              norm1_g, w_in, ssm_log_dt, ssm_a_re, ssm_a_im, ssm_b_re, ssm_b_im, ssm_c_re, ssm_c_im,
              ssm_d, ssm_w_glu, ssm_b_glu, pool_w, pool_scale, out_norm_att, out_norm_ssm,
              out_norm_pool, w_out, norm2_g, w_up, conv_w, conv_b, w_down, norm_f_g):
    f32 = jnp.float32
    xp = x_prompt.astype(f32)
    xs = x_sample.astype(f32)
    bp = xp.shape[0]
    st_p, st_s = [], []
    for i in range(DEPTH):
        lw = {'norm1_g': norm1_g[i], 'w_in': w_in[i], 'ssm_log_dt': ssm_log_dt[i],
              'ssm_a_re': ssm_a_re[i], 'ssm_a_im': ssm_a_im[i], 'ssm_b_re': ssm_b_re[i],
              'ssm_b_im': ssm_b_im[i], 'ssm_c_re': ssm_c_re[i], 'ssm_c_im': ssm_c_im[i],
              'ssm_d': ssm_d[i], 'ssm_w_glu': ssm_w_glu[i], 'ssm_b_glu': ssm_b_glu[i],
              'pool_w': pool_w[i], 'pool_scale': pool_scale[i], 'out_norm_att': out_norm_att[i],
              'out_norm_ssm': out_norm_ssm[i], 'out_norm_pool': out_norm_pool[i], 'w_out': w_out[i],
              'norm2_g': norm2_g[i], 'w_up': w_up[i], 'conv_w': conv_w[i], 'conv_b': conv_b[i],
              'w_down': w_down[i]}
        zero_h = jnp.zeros((bp, N_SSM_GROUPS, SSM_STATE), f32)
        xp, sp = _layer(xp, lw, None, None, zero_h, zero_h,
                        jnp.zeros((bp, POOL_BUF, D_POOL), f32),
                        jnp.zeros((bp, CONV_BUF, 2 * D_FF), f32), 0, True)
        xs, ss = _layer(xs, lw, cache_k[i], cache_v[i], state_ssm_re[i], state_ssm_im[i],
                        state_pool[i], state_conv[i], PAST_LEN, False)
        st_p.append(sp)
        st_s.append(ss)
    y_prompt = _rmsnorm(xp, norm_f_g).astype(x_prompt.dtype)
    y_sample = _rmsnorm(xs, norm_f_g).astype(x_sample.dtype)
    new_k_prompt = jnp.stack([s[0] for s in st_p], 0)
    new_v_prompt = jnp.stack([s[1] for s in st_p], 0)
    new_ssm_re_prompt = jnp.stack([s[2] for s in st_p], 0)
    new_ssm_im_prompt = jnp.stack([s[3] for s in st_p], 0)
    new_pool_prompt = jnp.stack([s[4] for s in st_p], 0)
    new_conv_prompt = jnp.stack([s[5] for s in st_p], 0)
    new_k_sample = jnp.stack([s[0] for s in st_s], 0)
    new_v_sample = jnp.stack([s[1] for s in st_s], 0)
    new_ssm_re_sample = jnp.stack([s[2] for s in st_s], 0)
    new_ssm_im_sample = jnp.stack([s[3] for s in st_s], 0)
    new_pool_sample = jnp.stack([s[4] for s in st_s], 0)
    new_conv_sample = jnp.stack([s[5] for s in st_s], 0)
    return (y_prompt, y_sample, new_k_prompt, new_v_prompt, new_ssm_re_prompt, new_ssm_im_prompt,
            new_pool_prompt, new_conv_prompt, new_k_sample, new_v_sample, new_ssm_re_sample,
            new_ssm_im_sample, new_pool_sample, new_conv_sample)
```

```cpp
#include <hip/hip_runtime.h>
#include <hip/hip_cooperative_groups.h>
#include <cstdio>
#include <cstdint>
namespace pg8 {
#define PG8_LAS __attribute__((address_space(3)))
typedef unsigned short bf16_t;
typedef short bf16x8 __attribute__((ext_vector_type(8)));
typedef float f32x4 __attribute__((ext_vector_type(4)));
typedef unsigned u32x4 __attribute__((ext_vector_type(4)));
constexpr int BM = 256, BK = 64, HALF = 128, HTB = HALF * BK * 2  , STAGE_BYTES = 8 * HTB, NXCD = 8, WGM = 8;

__host__ __device__ __forceinline__ int lds_byte(int r, int c) { const int st = (r >> 4) * 2 + (c >> 5), rr = r & 15, cc = c & 31, ob = rr * 64 + cc * 2; return st * 1024 + (ob ^ (((ob >> 9) & 1) << 5)); }
__host__ __device__ __forceinline__ void stage_rc(int b, int& R, int& C) { const int st = b / 1024, sb = b % 1024, swz = sb ^ (((sb >> 9) & 1) << 5); R = (st >> 1) * 16 + swz / 64; C = (st & 1) * 32 + (swz % 64) / 2; }
__host__ __device__ __forceinline__ int perm32(int rho) { const int n = rho >> 4, i = rho & 15; return 8 * (i >> 2) + 4 * n + (i & 3); }

struct Unit { int pm, pn; };
struct Gemm { const bf16_t* A; const bf16_t* Bt; int M, N, K; };

struct StaticOrder {
    int nM, nN, nwg, G, c;
    __host__ __device__ void init(int M, int N, int G_, int c_) { nM = M / BM; nN = N / BM; nwg = nM * nN; G = G_; c = c_; }
    __host__ __device__ bool next(int i, Unit& u) const {
        const long L = (long)i * G + c; if (L >= nwg) return false;
        int wgid = (int)L; { const int q = nwg / NXCD, r = nwg % NXCD, xcd = wgid % NXCD, off = wgid / NXCD; wgid = (xcd < r ? xcd * (q + 1) : r * (q + 1) + (xcd - r) * q) + off; }
        const int nig = WGM * nN, gid = wgid / nig, fm = gid * WGM, gsz = (nM - fm) < WGM ? (nM - fm) : WGM;
        u.pm = fm + ((wgid % nig) % gsz); u.pn = (wgid % nig) / gsz; return true;
    }
    __device__ __forceinline__ void a_ready(const Unit&) const {}
    __device__ __forceinline__ void done(const Unit&) const {}
};

__device__ __forceinline__ unsigned cvt_pk_bf16(float lo, float hi) { unsigned r; asm volatile("v_cvt_pk_bf16_f32 %0, %1, %2" : "=v"(r) : "v"(lo), "v"(hi)); return r; }
typedef float f32x2 __attribute__((ext_vector_type(2)));
__device__ __forceinline__ f32x2 gelu_pk(f32x2 v) {
    const f32x2 av = __builtin_elementwise_abs(v), d = av * 0.2316418882f + 1.0f;
    f32x2 t; t.x = __builtin_amdgcn_rcpf(d.x); t.y = __builtin_amdgcn_rcpf(d.y);
    f32x2 q = t * 0.5307027145f + (-0.7265760135f); q = q * t + 0.7107068705f; q = q * t + (-0.142248368f); q = q * t + 0.127414796f; q = q * t;
    const f32x2 s = (v * v) * (-0.72134752044f);
    f32x2 e; e.x = __builtin_amdgcn_exp2f(s.x); e.y = __builtin_amdgcn_exp2f(s.y);
    const f32x2 m = v * (q * e), r = v - m;
    f32x2 o; o.x = v.x < 0.f ? m.x : r.x; o.y = v.y < 0.f ? m.y : r.y; return o;
}

template <int ACT  > struct EpiBf16 {
    static constexpr bool PERM = true, AFTER_DRAIN = false; static_assert(ACT == 0 || ACT == 1, "EpiBf16: ACT is 0 (none) or 1 (gelu_pk)");
    bf16_t* O; int ldc; const float* bias; int split_cols; size_t split_stride; float scale0;
    __device__ __forceinline__ void operator()(const f32x4 (&acc)[2][2][4][2], const Unit& u, int wr, int wc, int fr, int fq) const {
        const int row0 = u.pm * BM + wr * 64 + fr; int colt = u.pn * BM; bf16_t* base = O;
        float sc = 1.f; if (split_cols) { const int t = colt / split_cols; base += (size_t)t * split_stride; colt -= t * split_cols; if (t == 0) sc = scale0; }
        const int col0 = colt + wc * 32 + 8 * fq, bcol0 = u.pn * BM + wc * 32 + 8 * fq;
        f32x4 bv[2][2];
#pragma unroll
        for (int bj = 0; bj < 2; ++bj)
#pragma unroll
            for (int n = 0; n < 2; ++n) bv[bj][n] = bias ? *(const f32x4*)(bias + bcol0 + bj * HALF + 4 * n) : (f32x4){0.f, 0.f, 0.f, 0.f};
#pragma unroll
        for (int ai = 0; ai < 2; ++ai)
#pragma unroll
            for (int m = 0; m < 4; ++m) { bf16_t* rowp = base + (size_t)(row0 + ai * HALF + m * 16) * ldc + col0;
#pragma unroll
                for (int bj = 0; bj < 2; ++bj) { f32x4 v0 = acc[ai][bj][m][0] + bv[bj][0], v1 = acc[ai][bj][m][1] + bv[bj][1];
                    if (ACT == 1) { f32x2 a = gelu_pk((f32x2){v0[0], v0[1]}), b = gelu_pk((f32x2){v0[2], v0[3]}), c = gelu_pk((f32x2){v1[0], v1[1]}), d = gelu_pk((f32x2){v1[2], v1[3]});
                        v0 = (f32x4){a.x, a.y, b.x, b.y}; v1 = (f32x4){c.x, c.y, d.x, d.y}; }
                    v0 = v0 * sc; v1 = v1 * sc; u32x4 w; w.x = cvt_pk_bf16(v0[0], v0[1]); w.y = cvt_pk_bf16(v0[2], v0[3]); w.z = cvt_pk_bf16(v1[0], v1[1]); w.w = cvt_pk_bf16(v1[2], v1[3]);
                    *(u32x4*)(rowp + bj * HALF) = w; } }
    }
};
template <class Epi, class Sched, bool ALIGN_EPI = false, bool SP2 = false>
__device__ __forceinline__ void gemm_phase(PG8_LAS unsigned char* lds, const Gemm g, const Sched& S, const Epi& E) {
    int tid_ = threadIdx.x; asm volatile("" : "+v"(tid_));
    const int tid = tid_, wid = __builtin_amdgcn_readfirstlane(tid >> 6), lane = tid & 63, wr = wid >> 2, wc = wid & 3, fr = lane & 15, fq = lane >> 4;
    const int K = g.K, nt = K / BK;
    unsigned voffA[2], voffB[2];
#pragma unroll
    for (int i = 0; i < 2; ++i) { int R, C; stage_rc(tid * 16 + i * 8192, R, C); const int Rb = Epi::PERM ? ((R & ~31) + perm32(R & 31)) : R;
        voffA[i] = (unsigned)(R * K + C) * 2u; voffB[i] = (unsigned)(Rb * K + C) * 2u; }
    const size_t kstep = (size_t)(BK * 2);
    const size_t hstep = (size_t)HALF * K * 2;
    const size_t tstep = 2 * hstep;
    const unsigned ldsw = (unsigned)wid * 1024u;
    const int aoff = lds_byte(wr * 64 + fr, fq * 8), boff = lds_byte(wc * 32 + fr, fq * 8);
#define PG8_SA(b, h) (((b) * 2 + (h)) * HTB)
#define PG8_SB(b, h) ((4 + (b) * 2 + (h)) * HTB)
#define PG8_STAGE(bufoff, gbase, voff) do { _Pragma("unroll") for (int _i = 0; _i < 2; ++_i) \
        __builtin_amdgcn_global_load_lds((const unsigned*)((const char*)(gbase) + (voff)[_i]), (PG8_LAS unsigned*)(lds + (bufoff) + ldsw + _i * 8192), 16, 0, 0); } while (0)
#define PG8_LDA(dst, b, h) do { _Pragma("unroll") for (int m = 0; m < 4; ++m) _Pragma("unroll") for (int k = 0; k < 2; ++k) dst[m][k] = *(const PG8_LAS bf16x8*)(lds + PG8_SA(b, h) + aoff + m * 2048 + k * 1024); } while (0)
#define PG8_LDB(dst, b, h) do { _Pragma("unroll") for (int n = 0; n < 2; ++n) _Pragma("unroll") for (int k = 0; k < 2; ++k) dst[n][k] = *(const PG8_LAS bf16x8*)(lds + PG8_SB(b, h) + boff + n * 2048 + k * 1024); } while (0)
#define PG8_MMA(ai, bj, At, Bt) do { __builtin_amdgcn_s_setprio(1); _Pragma("unroll") for (int m = 0; m < 4; ++m) _Pragma("unroll") for (int n = 0; n < 2; ++n) _Pragma("unroll") for (int k = 0; k < 2; ++k) \
        acc[ai][bj][m][n] = __builtin_amdgcn_mfma_f32_16x16x32_bf16(Bt[n][k], At[m][k], acc[ai][bj][m][n], 0, 0, 0); __builtin_amdgcn_s_setprio(0); } while (0)
#define PG8_WAIT_V(n) asm volatile("s_waitcnt vmcnt(" #n ")" ::: "memory")
#define PG8_WAIT_L(n) asm volatile("s_waitcnt lgkmcnt(" #n ")" ::: "memory")
#define PG8_BAR __builtin_amdgcn_s_barrier()
#define PG8_SCHED __builtin_amdgcn_sched_barrier(0)
    Unit cur, nxt; int ui = 0;
    if (!S.next(0, cur)) return;
    f32x4 acc[2][2][4][2];
#pragma unroll
    for (int a = 0; a < 2; ++a)
#pragma unroll
        for (int b = 0; b < 2; ++b)
#pragma unroll
            for (int m = 0; m < 4; ++m)
#pragma unroll
                for (int n = 0; n < 2; ++n) acc[a][b][m][n] = (f32x4){0.f, 0.f, 0.f, 0.f};
    bf16x8 At[4][2], B0[2][2], B1[2][2];
    const char* cA = (const char*)g.A + (size_t)cur.pm * tstep; const char* cB = (const char*)g.Bt + (size_t)cur.pn * tstep;
    S.a_ready(cur);
    if constexpr (SP2) {
        PG8_STAGE(PG8_SB(0, 0), cB, voffB); PG8_STAGE(PG8_SB(0, 1), cB + hstep, voffB); PG8_STAGE(PG8_SA(0, 0), cA, voffA); PG8_STAGE(PG8_SA(0, 1), cA + hstep, voffA);
        if (wr == 1) PG8_BAR;
        PG8_WAIT_V(2); PG8_BAR;
        PG8_STAGE(PG8_SB(1, 0), cB + kstep, voffB); PG8_STAGE(PG8_SA(1, 0), cA + kstep, voffA); PG8_STAGE(PG8_SB(1, 1), cB + hstep + kstep, voffB);
        PG8_WAIT_V(6); PG8_BAR;
    } else {
        PG8_STAGE(PG8_SB(0, 0), cB, voffB); PG8_STAGE(PG8_SA(0, 0), cA, voffA); PG8_STAGE(PG8_SB(0, 1), cB + hstep, voffB); PG8_STAGE(PG8_SA(0, 1), cA + hstep, voffA);
        if (wr == 1) PG8_BAR;
        PG8_WAIT_V(4); PG8_BAR;
        PG8_STAGE(PG8_SB(1, 0), cB + kstep, voffB); PG8_STAGE(PG8_SA(1, 0), cA + kstep, voffA); PG8_STAGE(PG8_SB(1, 1), cB + hstep + kstep, voffB);
        PG8_WAIT_V(6); PG8_BAR;
    }
    for (;;) {
        const bool has_next = S.next(ui + 1, nxt);
        const char* nA = has_next ? (const char*)g.A + (size_t)nxt.pm * tstep : cA; const char* nB = has_next ? (const char*)g.Bt + (size_t)nxt.pn * tstep : cB;
        for (int t = 0; t < nt; t += 2) {
            const bool last = (t == nt - 2);
            const char* a1 = cA + (size_t)(t + 1) * kstep;
            const char* a2 = last ? nA : cA + (size_t)(t + 2) * kstep; const char* b2 = last ? nB : cB + (size_t)(t + 2) * kstep;
            const char* a3 = a2 + kstep; const char* b3 = b2 + kstep;
            if (last && has_next) S.a_ready(nxt);
            if constexpr (SP2) {
            PG8_LDB(B0, 0, 0); PG8_LDB(B1, 0, 1); PG8_SCHED; PG8_LDA(At, 0, 0); PG8_STAGE(PG8_SA(1, 1), a1 + hstep, voffA);
            PG8_WAIT_V(8); PG8_WAIT_L(0); PG8_BAR; PG8_MMA(0, 0, At, B0); PG8_MMA(0, 1, At, B1); PG8_BAR; PG8_SCHED;
            PG8_LDA(At, 0, 1); PG8_STAGE(PG8_SB(0, 0), b2, voffB); PG8_STAGE(PG8_SB(0, 1), b2 + hstep, voffB); PG8_STAGE(PG8_SA(0, 0), a2, voffA);
            PG8_WAIT_V(8); PG8_WAIT_L(0); PG8_BAR; PG8_MMA(1, 0, At, B0); PG8_MMA(1, 1, At, B1); PG8_BAR; PG8_SCHED;
            PG8_LDB(B0, 1, 0); PG8_LDB(B1, 1, 1); PG8_SCHED; PG8_LDA(At, 1, 0); PG8_STAGE(PG8_SA(0, 1), a2 + hstep, voffA);
            PG8_WAIT_V(8); PG8_WAIT_L(0); PG8_BAR; PG8_MMA(0, 0, At, B0); PG8_MMA(0, 1, At, B1); PG8_BAR; PG8_SCHED;
            PG8_LDA(At, 1, 1); PG8_STAGE(PG8_SB(1, 0), b3, voffB); PG8_STAGE(PG8_SB(1, 1), b3 + hstep, voffB); PG8_STAGE(PG8_SA(1, 0), a3, voffA);
            PG8_WAIT_V(8); PG8_WAIT_L(0); PG8_BAR; PG8_MMA(1, 0, At, B0); PG8_MMA(1, 1, At, B1); PG8_BAR; PG8_SCHED;
            } else {
            PG8_LDB(B0, 0, 0); PG8_SCHED; PG8_LDA(At, 0, 0); PG8_STAGE(PG8_SA(1, 1), a1 + hstep, voffA);
            PG8_WAIT_L(8); PG8_BAR; PG8_WAIT_L(0); PG8_MMA(0, 0, At, B0); PG8_BAR; PG8_SCHED;
            PG8_LDB(B1, 0, 1); PG8_STAGE(PG8_SB(0, 0), b2, voffB);
            PG8_BAR; PG8_WAIT_L(0); PG8_MMA(0, 1, At, B1); PG8_BAR;
            PG8_LDA(At, 0, 1); PG8_STAGE(PG8_SA(0, 0), a2, voffA);
            PG8_BAR; PG8_WAIT_L(0); PG8_MMA(1, 0, At, B0); PG8_BAR; PG8_SCHED;
            PG8_STAGE(PG8_SB(0, 1), b2 + hstep, voffB);
            PG8_WAIT_V(6); PG8_BAR; PG8_MMA(1, 1, At, B1); PG8_BAR;
            PG8_LDB(B0, 1, 0); PG8_SCHED; PG8_LDA(At, 1, 0); PG8_STAGE(PG8_SA(0, 1), a2 + hstep, voffA);
            PG8_WAIT_L(8); PG8_BAR; PG8_WAIT_L(0); PG8_MMA(0, 0, At, B0); PG8_BAR; PG8_SCHED;
            PG8_LDB(B1, 1, 1); PG8_STAGE(PG8_SB(1, 0), b3, voffB);
            PG8_BAR; PG8_WAIT_L(0); PG8_MMA(0, 1, At, B1); PG8_BAR;
            PG8_LDA(At, 1, 1); PG8_STAGE(PG8_SA(1, 0), a3, voffA);
            PG8_BAR; PG8_WAIT_L(0); PG8_MMA(1, 0, At, B0); PG8_BAR; PG8_SCHED;
            PG8_STAGE(PG8_SB(1, 1), b3 + hstep, voffB);
            PG8_WAIT_V(6); PG8_BAR; PG8_MMA(1, 1, At, B1); PG8_BAR;
            }
        }
        if constexpr (ALIGN_EPI) { if (wr == 0) PG8_BAR; }
        if constexpr (!Epi::AFTER_DRAIN) { E(acc, cur, wr, wc, fr, fq); S.done(cur); }
        if (!has_next) break;
#pragma unroll
        for (int a = 0; a < 2; ++a)
#pragma unroll
            for (int b = 0; b < 2; ++b)
#pragma unroll
                for (int m = 0; m < 4; ++m)
#pragma unroll
                    for (int n = 0; n < 2; ++n) acc[a][b][m][n] = (f32x4){0.f, 0.f, 0.f, 0.f};
        cur = nxt; cA = nA; cB = nB; ++ui;
        if constexpr (ALIGN_EPI) { if (wr == 1) PG8_BAR; }
    }
    PG8_WAIT_V(0);
    if constexpr (!ALIGN_EPI) { if (wr == 0) PG8_BAR; }
    PG8_BAR;
    if constexpr (Epi::AFTER_DRAIN) { E.fused(acc, cur, wr, wc, fr, fq, lds, wid, lane); S.done(cur); }
#undef PG8_SA
#undef PG8_SB
#undef PG8_STAGE
#undef PG8_LDA
#undef PG8_LDB
#undef PG8_MMA
#undef PG8_WAIT_V
#undef PG8_WAIT_L
#undef PG8_BAR
#undef PG8_SCHED
}
}

constexpr int DM = 1024, SEQ = 8192, MP = 16384, MS = 256, MT = MP + MS, NL = 2;
constexpr int DATT = 512, NH = 8, HD = 64, DSSM = 256, DPOOL = 256, DIN = 2048, DFF = 2816, DUP = 5632;
constexpr int LATT = 2048;
constexpr float EPS = 1e-6f;
constexpr float QSCALE = 0.125f * 1.4426950408889634f;

constexpr size_t O_YP = 0;
constexpr size_t O_YS = O_YP + (size_t)MP * DM;
constexpr size_t O_KP = O_YS + (size_t)MS * DM;
constexpr size_t O_VP = O_KP + (size_t)NL * 2 * LATT * DATT;
constexpr size_t O_SRP = O_VP + (size_t)NL * 2 * LATT * DATT;
constexpr size_t O_SIP = O_SRP + (size_t)NL * 2 * 16 * 64;
constexpr size_t O_PP = O_SIP + (size_t)NL * 2 * 16 * 64;
constexpr size_t O_CP = O_PP + (size_t)NL * 2 * 15 * 256;
constexpr size_t O_KS = O_CP + (size_t)NL * 2 * 2 * DUP;
constexpr size_t O_VS = O_KS + (size_t)NL * MS * DATT;
constexpr size_t O_SRS = O_VS + (size_t)NL * MS * DATT;
constexpr size_t O_SIS = O_SRS + (size_t)NL * 32 * 16 * 64;
constexpr size_t O_PS = O_SIS + (size_t)NL * 32 * 16 * 64;
constexpr size_t O_CS = O_PS + (size_t)NL * 32 * 15 * 256;
constexpr size_t O_END = O_CS + (size_t)NL * 32 * 2 * DUP;
static_assert(O_END == 27118592, "output size");

constexpr size_t MiB = 1u << 20;
constexpr size_t WS_CTL = 0, CTL_ZERO_BYTES = 1 * MiB;
constexpr size_t WS_TAB = 1 * MiB;
constexpr size_t WS_WIN = 2 * MiB;
constexpr size_t WS_WOUT = 10 * MiB;
constexpr size_t WS_WUP = 14 * MiB;
constexpr size_t WS_WDN = 36 * MiB;
constexpr size_t WS_RS1V0 = 48 * MiB, RS_VSTRIDE = 2 * MiB;
constexpr size_t WS_XBV0 = 54 * MiB, XB_VSTRIDE = 33 * MiB;
constexpr size_t WS_XFV0 = 219 * MiB, XF_VSTRIDE = 66 * MiB;
constexpr size_t WS_LAYER0 = 484 * MiB, LSTRIDE = 236 * MiB;
constexpr size_t WS_RS2 = 0 * MiB;
constexpr size_t WS_HEND = 2 * MiB;
constexpr size_t WS_QB = 4 * MiB;
constexpr size_t WS_KB = 21 * MiB;
constexpr size_t WS_VB = 38 * MiB;
constexpr size_t WS_US = 55 * MiB;
constexpr size_t WS_UPL = 72 * MiB;
constexpr size_t WS_MIX = 89 * MiB;
constexpr size_t WS_ACT = 122 * MiB;
constexpr size_t WS_HALO = 212 * MiB;
constexpr size_t WS_END = WS_LAYER0 + NL * LSTRIDE;
static_assert(WS_HALO + (size_t)260 * 4 * DUP * 4 <= LSTRIDE && WS_ACT + (size_t)MT * DFF * 2 <= WS_HALO && WS_MIX + (size_t)MT * DM * 2 <= WS_ACT && WS_UPL + (size_t)MT * 1024 <= WS_MIX, "layer block");
static_assert(WS_XBV0 + 5 * XB_VSTRIDE <= WS_XFV0 && WS_XFV0 + 4 * XF_VSTRIDE <= WS_LAYER0 && (size_t)MT * DM * 4 <= XF_VSTRIDE && (size_t)MT * DM * 2 <= XB_VSTRIDE, "residual versions");
static_assert(WS_WUP + (size_t)NL * DUP * DM * 2 <= WS_WDN && WS_WDN + (size_t)NL * DM * DFF * 2 <= WS_RS1V0 && WS_RS1V0 + 3 * RS_VSTRIDE <= WS_XBV0, "ws map");
constexpr int TAB_AB = 0;
constexpr int TAB_ABL = 2048;
constexpr int TAB_BB = 4096;
constexpr int TAB_PER_L = 4096 + 32768;
constexpr size_t WS_WG = WS_TAB + 512 * 1024;
constexpr size_t WS_PW = WS_TAB + 768 * 1024;

constexpr int LDS_BYTES = 147456;

#define GAS __attribute__((address_space(1)))
#define LAS __attribute__((address_space(3)))
typedef unsigned short bf16;
typedef unsigned v4u __attribute__((ext_vector_type(4)));
typedef unsigned v2u __attribute__((ext_vector_type(2)));
typedef float f32x4 __attribute__((ext_vector_type(4)));
using pg8::Unit;

__device__ __forceinline__ unsigned f2bf(float f) { unsigned u = __builtin_bit_cast(unsigned, f); return (u + 0x7fffu + ((u >> 16) & 1u)) >> 16; }
__device__ __forceinline__ unsigned pk2(float lo, float hi) { return f2bf(lo) | (f2bf(hi) << 16); }
__device__ __forceinline__ float bflo(unsigned w) { return __uint_as_float(w << 16); }
__device__ __forceinline__ float bfhi(unsigned w) { return __uint_as_float(w & 0xffff0000u); }
__device__ __forceinline__ float wave_sum(float v) {
#pragma unroll
    for (int o = 1; o < 64; o <<= 1) v += __shfl_xor(v, o);
    return v;
}
__device__ __forceinline__ float sigmoidf_(float x) { return __builtin_amdgcn_rcpf(1.0f + __builtin_amdgcn_exp2f(-1.4426950408889634f * x)); }
__device__ __forceinline__ float gelu_tanh(float x) {
    const float z = 0.7978845608028654f * (x + 0.044715f * x * x * x);
    const float t = 1.0f - 2.0f * __builtin_amdgcn_rcpf(1.0f + __builtin_amdgcn_exp2f(2.8853900817779268f * z));
    return 0.5f * x * (1.0f + t);
}


struct Args { const float* in[32]; float* out; unsigned char* ws; int ph_lo, ph_hi, probe_sub, probe_n; };

typedef const float* cfp;
typedef const __attribute__((address_space(4))) cfp* kin_t;
__device__ __forceinline__ kin_t kin() { kin_t p = (kin_t)__builtin_amdgcn_kernarg_segment_ptr(); asm volatile("" : "+s"(p)); return p; }

struct Frame {
    LAS unsigned char* lds;
    int tid, lane, wave, G, bx;
    unsigned char* wl;
    float* out; unsigned char* ws;
};
__device__ __forceinline__ unsigned char* layer_base(unsigned char* ws, int L) { return ws + WS_LAYER0 + (size_t)L * LSTRIDE; }

__device__ __forceinline__ void transpose_item(const float* W, int K, int N, bf16* WT, int gmode, const float* g0, const float* g1, const float* g2,
                                               bool perm_up, LAS float* scr, int item, int lane) {
    const int nblk = N / 32, kb = item / nblk, nb = item % nblk, k0 = 64 * kb, n0 = 32 * nb;
#pragma unroll 8
    for (int i = 0; i < 32; ++i) {
        const int kk = 2 * i + (lane >> 5), k = k0 + kk;
        float g = 1.0f;
        if (gmode == 1) g = g0[k];
        else if (gmode == 2) g = (k < 512) ? g0[k] : (k < 768 ? g1[k - 512] : g2[k - 768]);
        scr[kk * 33 + (lane & 31)] = W[(size_t)k * N + n0 + (lane & 31)] * g;
    }
    asm volatile("s_waitcnt lgkmcnt(0)" ::: "memory");
    int nr0 = n0;
    if (perm_up) { nr0 = (n0 < DFF) ? (256 * (n0 / 128) + (n0 % 128)) : (256 * ((n0 - DFF) / 128) + 128 + ((n0 - DFF) % 128)); }
    const int c = lane & 7;
#pragma unroll
    for (int j = 0; j < 4; ++j) {
        const int n = (lane >> 3) + 8 * j; const LAS float* s = scr + (8 * c) * 33 + n;
        v4u o; o.x = pk2(s[0 * 33], s[1 * 33]); o.y = pk2(s[2 * 33], s[3 * 33]); o.z = pk2(s[4 * 33], s[5 * 33]); o.w = pk2(s[6 * 33], s[7 * 33]);
        *(GAS v4u*)(WT + (size_t)(nr0 + n) * K + k0 + 8 * c) = o;
    }
    asm volatile("s_waitcnt lgkmcnt(0)" ::: "memory");
}

__device__ __forceinline__ void ph_prologue(Frame& F) {
    const kin_t IN = kin();
    LAS float* scr = (LAS float*)(F.lds + F.wave * 16384);
    const int gw = F.bx * 8 + F.wave, NGW = F.G * 8;
    constexpr int I_IN = 16 * 64, I_OUT = 16 * 32, I_UP = 16 * 176, I_DN = 44 * 32, I_WG = 4 * 8, I_PW = 4 * 2, PER_L = I_IN + I_OUT + I_UP + I_DN + I_WG + I_PW;
    for (int it = gw; it < NL * PER_L; it += NGW) {
        const int L = it / PER_L; int r = it % PER_L;
        if (r < I_IN) { transpose_item(IN[9] + (size_t)L * DM * DIN, DM, DIN, (bf16*)(F.ws + WS_WIN) + (size_t)L * DIN * DM, 1, IN[8] + L * DM, nullptr, nullptr, false, scr, r, F.lane); continue; }
        r -= I_IN;
        if (r < I_OUT) { transpose_item(IN[25] + (size_t)L * DM * DM, DM, DM, (bf16*)(F.ws + WS_WOUT) + (size_t)L * DM * DM, 2, IN[22] + L * 512, IN[23] + L * 256, IN[24] + L * 256, false, scr, r, F.lane); continue; }
        r -= I_OUT;
        if (r < I_UP) { transpose_item(IN[27] + (size_t)L * DM * DUP, DM, DUP, (bf16*)(F.ws + WS_WUP) + (size_t)L * DUP * DM, 1, IN[26] + L * DM, nullptr, nullptr, true, scr, r, F.lane); continue; }
        r -= I_UP;
        if (r < I_DN) { transpose_item(IN[30] + (size_t)L * DFF * DM, DFF, DM, (bf16*)(F.ws + WS_WDN) + (size_t)L * DM * DFF, 0, nullptr, nullptr, nullptr, false, scr, r, F.lane); continue; }
        r -= I_DN;
        if (r < I_WG) { transpose_item(IN[18] + (size_t)L * 65536, 256, 256, (bf16*)(F.ws + WS_WG) + (size_t)L * 65536, 0, nullptr, nullptr, nullptr, false, scr, r, F.lane); continue; }
        r -= I_WG;
        { const int gi = r >> 1; transpose_item(IN[20] + (size_t)(L * 4 + gi) * 4096, 64, 64, (bf16*)(F.ws + WS_PW) + (size_t)(L * 4 + gi) * 4096, 0, nullptr, nullptr, nullptr, false, scr, r & 1, F.lane); }
    }
    bf16* Xb = (bf16*)(F.ws + WS_XBV0); float* rs1 = (float*)(F.ws + WS_RS1V0);
    for (int blk = F.bx; blk < MT / 32; blk += F.G) {
#pragma unroll 1
        for (int r4 = 0; r4 < 4; ++r4) {
            const int m = blk * 32 + F.wave * 4 + r4;
            const float* xrow = (m < MP) ? IN[0] + (size_t)m * DM : IN[1] + (size_t)(m - MP) * DM;
            const GAS f32x4* xr = (const GAS f32x4*)xrow + F.lane;
            GAS v2u* o8 = (GAS v2u*)(Xb + (size_t)m * DM) + F.lane;
#pragma unroll
            for (int j = 0; j < 4; ++j) {
                const f32x4 v = xr[64 * j];
                float s = (v.x * v.x + v.y * v.y) + (v.z * v.z + v.w * v.w);
                s += __shfl_xor(s, 1); s += __shfl_xor(s, 2); s += __shfl_xor(s, 4); s += __shfl_xor(s, 8);
                if ((F.lane & 15) == 0) rs1[(size_t)(4 * j + (F.lane >> 4)) * MT + m] = s;
                v2u w; w.x = pk2(v.x, v.y); w.y = pk2(v.z, v.w); o8[64 * j] = w;
            }
        }
    }
    const int gt = F.bx * 512 + F.tid;
    if (gt < NL * 1024) {
        const int L = gt >> 10, g = (gt >> 6) & 15, p = gt & 63;
        float* tab = (float*)(F.ws + WS_TAB) + (size_t)L * TAB_PER_L;
        const float dt = expf(IN[10][L * 16 + g]);
        const float are = IN[11][(L * 16 + g) * 64 + p], aim = IN[12][(L * 16 + g) * 64 + p];
        const float mag = expf(dt * are), ang = dt * aim;
        const float abr = mag * cosf(ang), abi = mag * sinf(ang);
        const float den = are * are + aim * aim, nre = abr - 1.0f, nim = abi;
        const float cor = (nre * are + nim * aim) / den, coi = (nim * are - nre * aim) / den;
        tab[TAB_AB + (g * 2 + 0) * 64 + p] = abr; tab[TAB_AB + (g * 2 + 1) * 64 + p] = abi;
        float pr = abr, pi = abi;
#pragma unroll
        for (int i = 0; i < 6; ++i) { const float nr = pr * pr - pi * pi, ni = 2.0f * pr * pi; pr = nr; pi = ni; }
        tab[TAB_ABL + (g * 2 + 0) * 64 + p] = pr; tab[TAB_ABL + (g * 2 + 1) * 64 + p] = pi;
        for (int c = 0; c < 16; ++c) {
            const float br = IN[13][((size_t)(L * 16 + g) * 64 + p) * 16 + c], bi = IN[14][((size_t)(L * 16 + g) * 64 + p) * 16 + c];
            tab[TAB_BB + (g * 32 + 2 * c) * 64 + p] = cor * br - coi * bi;
            tab[TAB_BB + (g * 32 + 2 * c + 1) * 64 + p] = cor * bi + coi * br;
        }
    }
    for (int i = gt; i < NL * 32 * 7 * 256; i += F.G * 512) {
        const int ch = i & 255, r = (i >> 8) % 7, lb = (i >> 8) / 7;
        F.out[O_PS + ((size_t)lb * 15 + r) * 256 + ch] = IN[6][((size_t)lb * 15 + 8 + r) * 256 + ch];
    }
}

__device__ __forceinline__ float rstd_from_partials(const float* rs, int row, float inv_n) {
    float ss = 0.f;
#pragma unroll
    for (int s = 0; s < 16; ++s) ss += rs[(size_t)s * MT + row];
    return rsqrtf(ss * inv_n + EPS);
}
__device__ __forceinline__ float rstd_from_partials_q(const float* rs, int row, int fq, float inv_n) {
    const float* p = rs + (size_t)(4 * fq) * MT + row;
    float ss = (p[0] + p[MT]) + (p[2 * (size_t)MT] + p[3 * (size_t)MT]);
    ss += __shfl_xor(ss, 16); ss += __shfl_xor(ss, 32);
    return rsqrtf(ss * inv_n + EPS);
}
__device__ __forceinline__ void st_bf4(bf16* p, f32x4 v) { v2u w; w.x = pk2(v.x, v.y); w.y = pk2(v.z, v.w); *(GAS v2u*)p = w; }

struct Epi1Ptrs { const float* rs; bf16 *Q, *K, *V; float *Us, *Upl, *okp, *ovp, *oks, *ovs, *opp, *ops; };
__device__ __forceinline__ Epi1Ptrs epi1_ptrs(unsigned char* ws_, float* out_, int L_) {
    Epi1Ptrs p; unsigned char* wl_ = layer_base(ws_, L_);
    p.rs = (const float*)(ws_ + WS_RS1V0 + (size_t)L_ * RS_VSTRIDE);
    p.Q = (bf16*)(wl_ + WS_QB); p.K = (bf16*)(wl_ + WS_KB); p.V = (bf16*)(wl_ + WS_VB); p.Us = (float*)(wl_ + WS_US); p.Upl = (float*)(wl_ + WS_UPL);
    p.okp = out_ + O_KP + (size_t)L_ * 2 * LATT * DATT; p.ovp = out_ + O_VP + (size_t)L_ * 2 * LATT * DATT;
    p.oks = out_ + O_KS + (size_t)L_ * MS * DATT; p.ovs = out_ + O_VS + (size_t)L_ * MS * DATT;
    p.opp = out_ + O_PP + (size_t)L_ * 2 * 15 * 256; p.ops = out_ + O_PS + (size_t)L_ * 32 * 15 * 256;
    return p;
}
__device__ __forceinline__ void epi1_store(const Epi1Ptrs& P, int row, int pn, int lc, const f32x4 v) {
    const bool samp = row >= MP; const int t = row & (SEQ - 1), b = row >> 13, srow = row - MP;
    if (pn < 2) { st_bf4(P.Q + (size_t)row * 512 + pn * 256 + lc, v * QSCALE); }
    else if (pn < 6) {
        const bool isk = pn < 4; const int col = (pn & 1) * 256 + lc;
        st_bf4((isk ? P.K : P.V) + (size_t)row * 512 + col, v);
        if (samp) *(GAS f32x4*)((isk ? P.oks : P.ovs) + (size_t)srow * 512 + col) = v;
        else if (t >= SEQ - LATT) *(GAS f32x4*)((isk ? P.okp : P.ovp) + ((size_t)b * LATT + (t - (SEQ - LATT))) * 512 + col) = v;
    } else if (pn == 6) { *(GAS f32x4*)(P.Us + (size_t)row * 256 + lc) = v; }
    else {
        *(GAS f32x4*)(P.Upl + (size_t)row * 256 + lc) = v;
        if (samp) *(GAS f32x4*)(P.ops + ((size_t)(srow >> 3) * 15 + 7 + (srow & 7)) * 256 + lc) = v;
        else if (t >= SEQ - 15) *(GAS f32x4*)(P.opp + ((size_t)b * 15 + (t - (SEQ - 15))) * 256 + lc) = v;
    }
}
struct Epi1 {
    static constexpr bool PERM = false, AFTER_DRAIN = false;
    unsigned char* ws; float* out; int L;
    __device__ __forceinline__ void operator()(const f32x4 (&acc)[2][2][4][2], const Unit& u, int wr, int wc, int fr, int fq) const {
        unsigned char* ws_ = ws; float* out_ = out; int L_ = L; asm volatile("" : "+s"(ws_), "+s"(out_), "+s"(L_));
        const Epi1Ptrs P = epi1_ptrs(ws_, out_, L_);
        const int pn = u.pn;
#pragma unroll
        for (int ai = 0; ai < 2; ++ai)
#pragma unroll
            for (int m = 0; m < 4; ++m) {
                const int row = u.pm * 256 + ai * 128 + wr * 64 + m * 16 + fr;
                const float rstd = rstd_from_partials_q(P.rs, row, fq, 1.0f / 1024.0f);
#pragma unroll
                for (int bj = 0; bj < 2; ++bj)
#pragma unroll
                    for (int n = 0; n < 2; ++n) epi1_store(P, row, pn, bj * 128 + wc * 32 + n * 16 + fq * 4, acc[ai][bj][m][n] * rstd);
                asm volatile("" ::: "memory");
            }
    }
};

struct EpiRes {
    static constexpr bool PERM = false, AFTER_DRAIN = false;
    unsigned char* ws; const float *xp, *xs;
    int xin_off, xf_off, xb_off, rs_off;
    __device__ __forceinline__ void operator()(const f32x4 (&acc)[2][2][4][2], const Unit& u, int wr, int wc, int fr, int fq) const {
        unsigned char* ws_ = ws; int ro_ = rs_off, xi_ = xin_off, xf_ = xf_off, xb_ = xb_off; asm volatile("" : "+s"(ws_), "+s"(ro_), "+s"(xi_), "+s"(xf_), "+s"(xb_));
        const float* Xin = (const float*)(ws_ + xi_); float* Xf = (float*)(ws_ + xf_); bf16* Xb = (bf16*)(ws_ + xb_); float* rso = (float*)(ws_ + ro_);
        const int pn = u.pn;
#pragma unroll
        for (int ai = 0; ai < 2; ++ai)
#pragma unroll
            for (int m = 0; m < 4; ++m) {
                const int row = u.pm * 256 + ai * 128 + wr * 64 + m * 16 + fr;
                const float* brow = xp ? (row < MP ? xp + (size_t)row * DM : xs + (size_t)(row - MP) * DM) : Xin + (size_t)row * DM;
                float ss = 0.f;
#pragma unroll
                for (int bj = 0; bj < 2; ++bj)
#pragma unroll
                    for (int n = 0; n < 2; ++n) {
                        const int col = pn * 256 + bj * 128 + wc * 32 + n * 16 + fq * 4;
                        const f32x4 v = acc[ai][bj][m][n] + *(const GAS f32x4*)(brow + col);
                        *(GAS f32x4*)(Xf + (size_t)row * DM + col) = v;
                        st_bf4(Xb + (size_t)row * DM + col, v);
                        ss += (v.x * v.x + v.y * v.y) + (v.z * v.z + v.w * v.w);
                    }
                ss += __shfl_xor(ss, 16); ss += __shfl_xor(ss, 32);
                if (fq == 0) rso[(size_t)(pn * 4 + wc) * MT + row] = ss;
                asm volatile("" ::: "memory");
            }
    }
};

template <int N> __device__ __forceinline__ float row_ror(float v) { return __builtin_bit_cast(float, __builtin_amdgcn_update_dpp(0, __builtin_bit_cast(int, v), 0x120 + N, 0xf, 0xf, false)); }
template <int N> __device__ __forceinline__ f32x4 row_ror4(const f32x4 v) { return (f32x4){row_ror<N>(v.x), row_ror<N>(v.y), row_ror<N>(v.z), row_ror<N>(v.w)}; }
__device__ __forceinline__ f32x4 sel4(bool c, const f32x4 a, const f32x4 b) { return (f32x4){c ? a.x : b.x, c ? a.y : b.y, c ? a.z : b.z, c ? a.w : b.w}; }
__device__ __forceinline__ f32x4 silu_gate4(const f32x4 g, const f32x4 a) { return (f32x4){g.x * sigmoidf_(g.x) * a.x, g.y * sigmoidf_(g.y) * a.y, g.z * sigmoidf_(g.z) * a.z, g.w * sigmoidf_(g.w) * a.w}; }

struct Epi3 {
    static constexpr bool PERM = false, AFTER_DRAIN = false;
    unsigned char* ws; float* out; int L; const float *cwp, *cbp, *scp;
    __device__ __forceinline__ void operator()(f32x4 (&acc)[2][2][4][2], const Unit& u, int wr, int wc, int fr, int fq) const {
        unsigned char* ws_ = ws; float* out_ = out; int L_ = L; asm volatile("" : "+s"(ws_), "+s"(out_), "+s"(L_));
        unsigned char* wl_ = layer_base(ws_, L_);
        const float* rs = (const float*)(wl_ + WS_RS2); bf16* Act = (bf16*)(wl_ + WS_ACT); float* halo = (float*)(wl_ + WS_HALO);
        float* ocp = out_ + O_CP + (size_t)L_ * 2 * 2 * DUP; float* ocs = out_ + O_CS + (size_t)L_ * 32 * 2 * DUP;
        const int pn = u.pn; const bool stile = u.pm == MP / 256;
#pragma unroll
        for (int ai = 0; ai < 2; ++ai)
#pragma unroll
            for (int m = 0; m < 4; ++m) {
                const int row = u.pm * 256 + ai * 128 + wr * 64 + m * 16 + fr;
                const float rstd = rstd_from_partials_q(rs, row, fq, 1.0f / 1024.0f);
                const int t = row & (SEQ - 1), b = row >> 13, srow = row - MP;
#pragma unroll
                for (int bj = 0; bj < 2; ++bj)
#pragma unroll
                    for (int n = 0; n < 2; ++n) {
                        const f32x4 v = acc[ai][bj][m][n] * rstd; acc[ai][bj][m][n] = v;
                        const int lc = bj * 128 + wc * 32 + n * 16 + fq * 4, oc = bj * DFF + 128 * pn + (lc - bj * 128);
                        if (stile) { if ((srow & 7) >= 6) *(GAS f32x4*)(ocs + ((size_t)(srow >> 3) * 2 + ((srow & 7) - 6)) * DUP + oc) = v; }
                        else {
                            if (t >= SEQ - 2) *(GAS f32x4*)(ocp + ((size_t)b * 2 + (t - (SEQ - 2))) * DUP + oc) = v;
                            if (m == 0 && fr < 2) *(GAS f32x4*)(halo + ((size_t)(row >> 6) * 4 + fr) * DUP + pn * 256 + lc) = v;
                            if (m == 3 && fr >= 14) *(GAS f32x4*)(halo + ((size_t)(row >> 6) * 4 + (fr - 12)) * DUP + pn * 256 + lc) = v;
                        }
                    }
            }
        f32x4 cwv[2][8];
#pragma unroll
        for (int n = 0; n < 2; ++n) {
            const int ca = 128 * pn + wc * 32 + n * 16 + fq * 4, cg = DFF + ca;
            cwv[n][0] = *(const GAS f32x4*)(cwp + ca); cwv[n][1] = *(const GAS f32x4*)(cwp + DUP + ca); cwv[n][2] = *(const GAS f32x4*)(cwp + 2 * DUP + ca); cwv[n][3] = *(const GAS f32x4*)(cbp + ca);
            cwv[n][4] = *(const GAS f32x4*)(cwp + cg); cwv[n][5] = *(const GAS f32x4*)(cwp + DUP + cg); cwv[n][6] = *(const GAS f32x4*)(cwp + 2 * DUP + cg); cwv[n][7] = *(const GAS f32x4*)(cbp + cg);
        }
#pragma unroll
        for (int n = 0; n < 2; ++n) {
            const int ca = 128 * pn + wc * 32 + n * 16 + fq * 4, cg = DFF + ca;
            const f32x4 wa0 = cwv[n][0], wa1 = cwv[n][1], wa2 = cwv[n][2], ba = cwv[n][3], wg0 = cwv[n][4], wg1 = cwv[n][5], wg2 = cwv[n][6], bg = cwv[n][7];
#pragma unroll
            for (int ai = 0; ai < 2; ++ai)
#pragma unroll
                for (int m = 0; m < 4; ++m) {
                    const int row = u.pm * 256 + ai * 128 + wr * 64 + m * 16 + fr;
                    const f32x4 xa = acc[ai][0][m][n], xg = acc[ai][1][m][n];
                    const f32x4 pa = acc[ai][0][m > 0 ? m - 1 : 0][n], pg = acc[ai][1][m > 0 ? m - 1 : 0][n];
                    f32x4 a1 = sel4(fr == 0, row_ror4<1>(pa), row_ror4<1>(xa)), a2 = sel4(fr < 2, row_ror4<2>(pa), row_ror4<2>(xa));
                    f32x4 g1 = sel4(fr == 0, row_ror4<1>(pg), row_ror4<1>(xg)), g2 = sel4(fr < 2, row_ror4<2>(pg), row_ror4<2>(xg));
                    bool store = m > 0 || fr >= 2;
                    if (stile) {
                        const int srow = row - MP, t = srow & 7; const float* pr = scp + (size_t)(srow >> 3) * 2 * DUP;
                        if (t == 0) { a1 = *(const GAS f32x4*)(pr + DUP + ca); g1 = *(const GAS f32x4*)(pr + DUP + cg); a2 = *(const GAS f32x4*)(pr + ca); g2 = *(const GAS f32x4*)(pr + cg); }
                        else if (t == 1) { a2 = *(const GAS f32x4*)(pr + DUP + ca); g2 = *(const GAS f32x4*)(pr + DUP + cg); }
                        store = true;
                    }
                    const f32x4 av = ba + a2 * wa0 + a1 * wa1 + xa * wa2, gv = bg + g2 * wg0 + g1 * wg1 + xg * wg2;
                    if (store) st_bf4(Act + (size_t)row * DFF + ca, silu_gate4(gv, av));
                }
        }
    }
};
#define XB_TMO      128
#define XB_XCNT(j)  (256  + 64 * (j))
#define XB_XSUB(j)  (1280 + 64 * (j))
#define XB_XGEN(j)  (2304 + 64 * (j))
#define XB_TOP      3328
#define XB_TOPGEN   3392
#define XCD_BAR_WORDS 3456
#define XB_SPIN_CAP (1u << 22)

__device__ __forceinline__ unsigned xb_ld(unsigned* p)              { return __hip_atomic_load(p, __ATOMIC_RELAXED, __HIP_MEMORY_SCOPE_AGENT); }
__device__ __forceinline__ unsigned xb_add(unsigned* p, unsigned v) { return __hip_atomic_fetch_add(p, v, __ATOMIC_RELAXED, __HIP_MEMORY_SCOPE_AGENT); }
__device__ __forceinline__ unsigned xb_xcc_id() { return (unsigned)__builtin_amdgcn_s_getreg((3 << 11) | 20) & 0xFu; }
#define XB_SPIN(cond, bar) do { unsigned _sp = 0; while (cond) { __builtin_amdgcn_s_sleep(1); \
    if ((++_sp & 255u) == 0u) { if (xb_ld(&(bar)[XB_TMO])) break; if (_sp > XB_SPIN_CAP) { atomicAdd(&(bar)[XB_TMO], 1u); break; } } } } while (0)

struct XcdBarrier {
    unsigned* bar; unsigned x;
    volatile LAS unsigned* st;
};

__device__ __forceinline__ XcdBarrier xcd_barrier_post(unsigned* bar, volatile LAS unsigned* st) {
    XcdBarrier b; b.bar = bar; b.x = xb_xcc_id(); b.st = st;
    if (threadIdx.x == 0) (void)xb_add(&bar[XB_XCNT(b.x)], 1u);
    return b;
}
__device__ __forceinline__ void xcd_barrier_complete(unsigned* bar, unsigned x, unsigned& nloc, unsigned& nx) {
    const unsigned G = gridDim.x * gridDim.y * gridDim.z;
    unsigned sum, cnt, mine, sp = 0u;
    for (;;) {
        sum = 0u; cnt = 0u; mine = 0u;
#pragma unroll
        for (unsigned j = 0; j < 16; ++j) { const unsigned c = xb_ld(&bar[XB_XCNT(j)]); sum += c; cnt += (c > 0u) ? 1u : 0u; mine = (j == x) ? c : mine; }
        if (sum == G) break;
        __builtin_amdgcn_s_sleep(1);
        if ((++sp & 255u) == 0u) { if (xb_ld(&bar[XB_TMO])) break; if (sp > XB_SPIN_CAP) { atomicAdd(&bar[XB_TMO], 1u); break; } }
    }
    nloc = mine > 0u ? mine : 1u; nx = cnt > 0u ? cnt : 1u;
}

__device__ __forceinline__ void xcd_barrier(const XcdBarrier& b) {
    asm volatile("s_waitcnt vmcnt(0)" ::: "memory");
    __syncthreads();
    if (threadIdx.x == 0) {
        unsigned* bar = b.bar;
        __builtin_amdgcn_s_waitcnt(0);
        unsigned nloc = b.st[0], nx = b.st[1];
        if (nloc == 0u) { xcd_barrier_complete(bar, b.x, nloc, nx); b.st[0] = nloc; b.st[1] = nx; }
        const unsigned old = xb_add(&bar[XB_XSUB(b.x)], 1u);
        const unsigned gen = old / nloc;
        if (old + 1u == (gen + 1u) * nloc) {
            __builtin_amdgcn_fence(__ATOMIC_RELEASE, "agent");
            asm volatile("s_waitcnt vmcnt(0)" ::: "memory");
            const unsigned og = xb_add(&bar[XB_TOP], 1u);
            const unsigned tg = og / nx;
            if (og + 1u == (tg + 1u) * nx) xb_add(&bar[XB_TOPGEN], 1u);
            else XB_SPIN(xb_ld(&bar[XB_TOPGEN]) == tg, bar);
            __builtin_amdgcn_fence(__ATOMIC_ACQUIRE, "agent");
            xb_add(&bar[XB_XGEN(b.x)], 1u);
            asm volatile("s_waitcnt vmcnt(0)" ::: "memory");
        } else {
            XB_SPIN(xb_ld(&bar[XB_XGEN(b.x)]) == gen, bar);
            __builtin_amdgcn_fence(__ATOMIC_ACQUIRE, "agent");
            asm volatile("s_waitcnt vmcnt(0)" ::: "memory");
        }
    }
    __syncthreads();
}

__device__ __forceinline__ float rdlane(float v, int l) { return __builtin_bit_cast(float, __builtin_amdgcn_readlane(__builtin_bit_cast(int, v), l)); }

__device__ __forceinline__ void ph_ssm1(Frame& F, int L) {
    const float* tab = (const float*)(F.ws + WS_TAB) + (size_t)L * TAB_PER_L;
    const float* Us = (const float*)(F.wl + WS_US);
    float* Hend = (float*)(F.wl + WS_HEND);
    for (int unit = F.bx; unit < 256; unit += F.G) {
        const int base = unit * 64;
        const int g0 = F.wave * 2, g1 = g0 + 1;
        const float ar0 = tab[TAB_AB + (g0 * 2 + 0) * 64 + F.lane], ai0 = tab[TAB_AB + (g0 * 2 + 1) * 64 + F.lane];
        const float ar1 = tab[TAB_AB + (g1 * 2 + 0) * 64 + F.lane], ai1 = tab[TAB_AB + (g1 * 2 + 1) * 64 + F.lane];
        float bb0[32], bb1[32];
#pragma unroll
        for (int c = 0; c < 32; ++c) { bb0[c] = tab[TAB_BB + (g0 * 32 + c) * 64 + F.lane]; bb1[c] = tab[TAB_BB + (g1 * 32 + c) * 64 + F.lane]; }
        float h0r = 0.f, h0i = 0.f, h1r = 0.f, h1i = 0.f;
        for (int s0 = 0; s0 < 64; s0 += 8) {
            float uv[8];
#pragma unroll
            for (int k = 0; k < 8; ++k) uv[k] = Us[(size_t)(base + s0 + k) * 256 + g0 * 16 + (F.lane & 31)];
#pragma unroll
            for (int k = 0; k < 8; ++k) {
                float b0r = 0.f, b0i = 0.f, b1r = 0.f, b1i = 0.f;
#pragma unroll
                for (int c = 0; c < 16; ++c) { const float u0 = rdlane(uv[k], c), u1 = rdlane(uv[k], 16 + c);
                    b0r += bb0[2 * c] * u0; b0i += bb0[2 * c + 1] * u0; b1r += bb1[2 * c] * u1; b1i += bb1[2 * c + 1] * u1; }
                const float n0r = ar0 * h0r - ai0 * h0i + b0r, n0i = ar0 * h0i + ai0 * h0r + b0i; h0r = n0r; h0i = n0i;
                const float n1r = ar1 * h1r - ai1 * h1i + b1r, n1i = ar1 * h1i + ai1 * h1r + b1i; h1r = n1r; h1i = n1i;
            }
        }
        Hend[((size_t)unit * 16 + g0) * 128 + F.lane] = h0r; Hend[((size_t)unit * 16 + g0) * 128 + 64 + F.lane] = h0i;
        Hend[((size_t)unit * 16 + g1) * 128 + F.lane] = h1r; Hend[((size_t)unit * 16 + g1) * 128 + 64 + F.lane] = h1i;
    }
}

__device__ __forceinline__ void ld16_bf(const bf16* p, float (&f)[16]) {
    const v4u a = *(const GAS v4u*)p, b = *(const GAS v4u*)(p + 8);
    f[0] = bflo(a.x); f[1] = bfhi(a.x); f[2] = bflo(a.y); f[3] = bfhi(a.y); f[4] = bflo(a.z); f[5] = bfhi(a.z); f[6] = bflo(a.w); f[7] = bfhi(a.w);
    f[8] = bflo(b.x); f[9] = bfhi(b.x); f[10] = bflo(b.y); f[11] = bfhi(b.y); f[12] = bflo(b.z); f[13] = bfhi(b.z); f[14] = bflo(b.w); f[15] = bfhi(b.w);
}
__device__ __forceinline__ void ld16_f32(const float* p, float (&f)[16]) {
    const GAS f32x4* q = (const GAS f32x4*)p;
#pragma unroll
    for (int i = 0; i < 4; ++i) { const f32x4 v = q[i]; f[4 * i] = v.x; f[4 * i + 1] = v.y; f[4 * i + 2] = v.z; f[4 * i + 3] = v.w; }
}

template <bool SAMPLE>
__device__ __forceinline__ void attn_row(const Frame& F, int L, int row, int bb, int t, int h, float (&o)[16]) {
    const kin_t IN = kin();
    const int ks = F.lane >> 2, dq = F.lane & 3;
    const bf16* Qb = (const bf16*)(F.wl + WS_QB); const bf16* Kb = (const bf16*)(F.wl + WS_KB); const bf16* Vb = (const bf16*)(F.wl + WS_VB);
    const float* ck = IN[2] + ((size_t)(L * 32 + bb) * LATT) * 512; const float* cv = IN[3] + ((size_t)(L * 32 + bb) * LATT) * 512;
    const int hoff = h * 64 + dq * 16;
    float q[16]; ld16_bf(Qb + (size_t)row * 512 + hoff, q);
    float m = -1e30f, l = 0.f, acc[16];
#pragma unroll
    for (int i = 0; i < 16; ++i) acc[i] = 0.f;
#pragma unroll 3
    for (int it = 0; it < 27; ++it) {
        const int gi = it / 9, s = it - gi * 9, d = 1 << (2 * gi);
        const int j = s * 16 + ks; bool valid = j <= 128; float k[16], v[16];
        if (!SAMPLE) { int pos = t - d * j; valid = valid && pos >= 0; if (!valid) pos = t;
                       ld16_bf(Kb + (size_t)(bb * SEQ + pos) * 512 + hoff, k); ld16_bf(Vb + (size_t)(bb * SEQ + pos) * 512 + hoff, v); }
        else { int idx = LATT + t - d * j; if (!valid) idx = LATT + t;
               if (idx >= LATT) { ld16_bf(Kb + (size_t)(MP + bb * 8 + (idx - LATT)) * 512 + hoff, k); ld16_bf(Vb + (size_t)(MP + bb * 8 + (idx - LATT)) * 512 + hoff, v); }
               else { ld16_f32(ck + (size_t)idx * 512 + hoff, k); ld16_f32(cv + (size_t)idx * 512 + hoff, v); } }
        float dot = 0.f;
#pragma unroll
        for (int i = 0; i < 16; ++i) dot += q[i] * k[i];
        dot += __shfl_xor(dot, 1); dot += __shfl_xor(dot, 2);
        dot = valid ? dot : -1e30f;
        const float mn = fmaxf(m, dot), sc = __builtin_amdgcn_exp2f(m - mn), p = __builtin_amdgcn_exp2f(dot - mn);
        m = mn; l = l * sc + p;
#pragma unroll
        for (int i = 0; i < 16; ++i) acc[i] = acc[i] * sc + p * v[i];
    }
    float M = m;
    M = fmaxf(M, __shfl_xor(M, 4)); M = fmaxf(M, __shfl_xor(M, 8)); M = fmaxf(M, __shfl_xor(M, 16)); M = fmaxf(M, __shfl_xor(M, 32));
    const float f = __builtin_amdgcn_exp2f(m - M);
    l *= f; l += __shfl_xor(l, 4); l += __shfl_xor(l, 8); l += __shfl_xor(l, 16); l += __shfl_xor(l, 32);
    const float rl = 1.0f / l;
#pragma unroll
    for (int i = 0; i < 16; ++i) { float a = acc[i] * f; a += __shfl_xor(a, 4); a += __shfl_xor(a, 8); a += __shfl_xor(a, 16); a += __shfl_xor(a, 32); o[i] = a * rl; }
}

__device__ __forceinline__ void attn_store(Frame& F, int row, int h, const float (&o)[16], int parity) {
    const int ks = F.lane >> 2, dq = F.lane & 3;
    float ss = 0.f;
#pragma unroll
    for (int i = 0; i < 16; ++i) ss += o[i] * o[i];
    ss += __shfl_xor(ss, 1); ss += __shfl_xor(ss, 2);
    LAS float* red = (LAS float*)F.lds + parity * 8;
    if (F.lane == 0) red[h] = ss;
    __syncthreads();
    float tot = 0.f;
#pragma unroll
    for (int w = 0; w < 8; ++w) tot += red[w];
    const float rstd = rsqrtf(tot * (1.0f / 512.0f) + EPS);
    if (ks == 0) {
        bf16* mp = (bf16*)(F.wl + WS_MIX) + (size_t)row * DM + h * 64 + dq * 16;
        v4u a, b;
        a.x = pk2(o[0] * rstd, o[1] * rstd); a.y = pk2(o[2] * rstd, o[3] * rstd); a.z = pk2(o[4] * rstd, o[5] * rstd); a.w = pk2(o[6] * rstd, o[7] * rstd);
        b.x = pk2(o[8] * rstd, o[9] * rstd); b.y = pk2(o[10] * rstd, o[11] * rstd); b.z = pk2(o[12] * rstd, o[13] * rstd); b.w = pk2(o[14] * rstd, o[15] * rstd);
        *(GAS v4u*)mp = a; *(GAS v4u*)(mp + 8) = b;
    }
}

typedef short bf16x8_t __attribute__((ext_vector_type(8)));
typedef short s16x4_t __attribute__((ext_vector_type(4)));
#define MFMA16(a, b, c) __builtin_amdgcn_mfma_f32_16x16x32_bf16((a), (b), (c), 0, 0, 0)
__device__ __forceinline__ bf16x8_t pack8(const f32x4 a, const f32x4 b) { v4u w; w.x = pk2(a.x, a.y); w.y = pk2(a.z, a.w); w.z = pk2(b.x, b.y); w.w = pk2(b.z, b.w); return __builtin_bit_cast(bf16x8_t, w); }

constexpr int GS_STRIDE = 264;
constexpr int SM_G_OFF = 0;
constexpr int SM_RED_OFF = 33792;
constexpr int SM_W_OFF = 36864, SM_W_BYTES = 8704;
static_assert(SM_W_OFF + 8 * SM_W_BYTES <= 131072, "ssm LDS");

__device__ __forceinline__ void rms_store_tile(Frame& F, const f32x4 (&o)[4][2], int base, int coff, int n0, int nmt) {
    const int c16 = F.lane & 15, g = F.lane >> 4;
    LAS float* red = (LAS float*)(F.lds + SM_RED_OFF);
#pragma unroll
    for (int mt = 0; mt < 4; ++mt) if (mt < nmt) {
        float ss = 0.f;
#pragma unroll
        for (int nt = 0; nt < 2; ++nt) ss += (o[mt][nt].x * o[mt][nt].x + o[mt][nt].y * o[mt][nt].y) + (o[mt][nt].z * o[mt][nt].z + o[mt][nt].w * o[mt][nt].w);
        ss += __shfl_xor(ss, 16); ss += __shfl_xor(ss, 32);
        if (g == 0) red[(mt * 16 + c16) * 8 + F.wave] = ss;
    }
    __syncthreads();
#pragma unroll
    for (int mt = 0; mt < 4; ++mt) if (mt < nmt) {
        const f32x4 a = *(const LAS f32x4*)(red + (mt * 16 + c16) * 8), b = *(const LAS f32x4*)(red + (mt * 16 + c16) * 8 + 4);
        const float rstd = rsqrtf((((a.x + a.y) + (a.z + a.w)) + ((b.x + b.y) + (b.z + b.w))) * (1.0f / 256.0f) + EPS);
        bf16* mp = (bf16*)(F.wl + WS_MIX) + (size_t)(base + mt * 16 + c16) * DM + coff + n0 + 4 * g;
#pragma unroll
        for (int nt = 0; nt < 2; ++nt) st_bf4(mp + 16 * nt, o[mt][nt] * rstd);
    }
}

__device__ __forceinline__ void ssm_unit(Frame& F, int L, int unit) {
    const kin_t IN = kin();
    const int lane = F.lane, c16 = lane & 15, g4 = lane >> 4;
    const float* tab = (const float*)(F.ws + WS_TAB) + (size_t)L * TAB_PER_L;
    const float* Us = (const float*)(F.wl + WS_US);
    const float* Hend = (const float*)(F.wl + WS_HEND);
    LAS bf16* Gs = (LAS bf16*)(F.lds + SM_G_OFF);
    LAS float* BUs = (LAS float*)(F.lds + SM_W_OFF + F.wave * SM_W_BYTES);
    LAS bf16* Hs = (LAS bf16*)BUs;
    const bool samp = unit >= 256; const int base = unit * 64, nsc = 4;
    const int b = unit >> 7, ci = unit & 127;
    for (int gg = 0; gg < 2; ++gg) {
        const int g = F.wave * 2 + gg;
        const float ar = tab[TAB_AB + (g * 2 + 0) * 64 + lane], ai = tab[TAB_AB + (g * 2 + 1) * 64 + lane];
        bf16x8_t bop[8];
#pragma unroll
        for (int nt = 0; nt < 8; ++nt) {
            const int ri = nt >> 2, p = (nt & 3) * 16 + c16;
            float t[8];
#pragma unroll
            for (int j = 0; j < 8; ++j) t[j] = (g4 < 2) ? tab[TAB_BB + (g * 32 + (8 * g4 + j) * 2 + ri) * 64 + p] : 0.f;
            bop[nt] = pack8((f32x4){t[0], t[1], t[2], t[3]}, (f32x4){t[4], t[5], t[6], t[7]});
        }
        bf16x8_t cop[4];
#pragma unroll
        for (int ks = 0; ks < 4; ++ks) {
            const int k0 = (32 * ks + 8 * g4) & 63; const bool im = ks >= 2;
            const float* cp = (im ? IN[16] : IN[15]) + ((size_t)(L * 16 + g) * 16 + c16) * 64 + k0;
            const f32x4 a = *(const GAS f32x4*)cp, c = *(const GAS f32x4*)(cp + 4);
            cop[ks] = im ? pack8(-a, -c) : pack8(a, c);
        }
        const float dsk = IN[17][L * 256 + g * 16 + c16];
        float hr = 0.f, hi = 0.f;
        if (!samp) {
            const float alr = tab[TAB_ABL + (g * 2 + 0) * 64 + lane], ali = tab[TAB_ABL + (g * 2 + 1) * 64 + lane];
            const float* he = Hend + ((size_t)(b * 128) * 16 + g) * 128 + lane;
            int j = 0;
            for (; j + 16 <= ci; j += 16) {
                float er[16], ei[16];
#pragma unroll
                for (int k = 0; k < 16; ++k) { er[k] = he[(size_t)(j + k) * 2048]; ei[k] = he[(size_t)(j + k) * 2048 + 64]; }
#pragma unroll
                for (int k = 0; k < 16; ++k) { const float nr = alr * hr - ali * hi + er[k], ni = alr * hi + ali * hr + ei[k]; hr = nr; hi = ni; }
            }
            for (; j < ci; ++j) { const float e0 = he[(size_t)j * 2048], e1 = he[(size_t)j * 2048 + 64]; const float nr = alr * hr - ali * hi + e0, ni = alr * hi + ali * hr + e1; hr = nr; hi = ni; }
        }
        bf16x8_t ua_n = (bf16x8_t){0, 0, 0, 0, 0, 0, 0, 0}; float usk_n[4];
        { if (g4 < 2) { const float* up = Us + (size_t)(base + c16) * 256 + g * 16 + 8 * g4; ua_n = pack8(*(const GAS f32x4*)up, *(const GAS f32x4*)(up + 4)); }
#pragma unroll
          for (int e = 0; e < 4; ++e) usk_n[e] = Us[(size_t)(base + 4 * g4 + e) * 256 + g * 16 + c16]; }
#pragma unroll 1
        for (int sc = 0; sc < nsc; ++sc) {
            const bf16x8_t ua = ua_n; float usk[4];
#pragma unroll
            for (int e = 0; e < 4; ++e) usk[e] = usk_n[e];
            if (sc + 1 < nsc) { const int r1 = base + (sc + 1) * 16;
                if (g4 < 2) { const float* up = Us + (size_t)(r1 + c16) * 256 + g * 16 + 8 * g4; ua_n = pack8(*(const GAS f32x4*)up, *(const GAS f32x4*)(up + 4)); }
#pragma unroll
                for (int e = 0; e < 4; ++e) usk_n[e] = Us[(size_t)(r1 + 4 * g4 + e) * 256 + g * 16 + c16]; }
#pragma unroll
            for (int nt = 0; nt < 8; ++nt) {
                const f32x4 d = MFMA16(ua, bop[nt], ((f32x4){0.f, 0.f, 0.f, 0.f}));
#pragma unroll
                for (int e = 0; e < 4; ++e) BUs[(4 * g4 + e) * 132 + nt * 16 + c16] = d[e];
            }
            float br[16], bi[16];
#pragma unroll
            for (int t = 0; t < 16; ++t) { br[t] = BUs[t * 132 + lane]; bi[t] = BUs[t * 132 + 64 + lane]; }
            asm volatile("s_waitcnt lgkmcnt(0)" ::: "memory");
#pragma unroll
            for (int t = 0; t < 16; ++t) {
                if (samp && (t & 7) == 0) { const int bs = (unit - 256) * 8 + sc * 2 + (t >> 3); hr = IN[4][((size_t)(L * 32 + bs) * 16 + g) * 64 + lane]; hi = IN[5][((size_t)(L * 32 + bs) * 16 + g) * 64 + lane]; }
                const float nhr = ar * hr - ai * hi + br[t], nhi = ar * hi + ai * hr + bi[t]; hr = nhr; hi = nhi;
                Hs[t * 136 + lane] = (bf16)f2bf(hr); Hs[t * 136 + 64 + lane] = (bf16)f2bf(hi);
                if (samp && (t & 7) == 7) { const int bs = (unit - 256) * 8 + sc * 2 + (t >> 3);
                    F.out[O_SRS + ((size_t)(L * 32 + bs) * 16 + g) * 64 + lane] = hr; F.out[O_SIS + ((size_t)(L * 32 + bs) * 16 + g) * 64 + lane] = hi; }
            }
            asm volatile("" ::: "memory");
            f32x4 y = (f32x4){0.f, 0.f, 0.f, 0.f};
#pragma unroll
            for (int ks = 0; ks < 4; ++ks) { const bf16x8_t ha = *(const LAS bf16x8_t*)(Hs + c16 * 136 + 32 * ks + 8 * g4); y = MFMA16(ha, cop[ks], y); }
#pragma unroll
            for (int e = 0; e < 4; ++e) Gs[(sc * 16 + 4 * g4 + e) * GS_STRIDE + g * 16 + c16] = (bf16)f2bf(gelu_tanh(y[e] + dsk * usk[e]));
            asm volatile("s_waitcnt lgkmcnt(0)" ::: "memory");
        }
        if (!samp && ci == 127) { F.out[O_SRP + ((size_t)(L * 2 + b) * 16 + g) * 64 + lane] = hr; F.out[O_SIP + ((size_t)(L * 2 + b) * 16 + g) * 64 + lane] = hi; }
    }
    __syncthreads();
    {
        const int n0 = 32 * F.wave;
        const bf16* Wt = (const bf16*)(F.ws + WS_WG) + (size_t)L * 65536;
        f32x4 acc[4][2];
#pragma unroll
        for (int mt = 0; mt < 4; ++mt) { acc[mt][0] = (f32x4){0.f, 0.f, 0.f, 0.f}; acc[mt][1] = acc[mt][0]; }
#pragma unroll
        for (int ks = 0; ks < 8; ++ks) {
            const bf16x8_t w0 = *(const GAS bf16x8_t*)(Wt + (size_t)(n0 + c16) * 256 + 32 * ks + 8 * g4), w1 = *(const GAS bf16x8_t*)(Wt + (size_t)(n0 + 16 + c16) * 256 + 32 * ks + 8 * g4);
#pragma unroll
            for (int mt = 0; mt < 4; ++mt) if (mt < nsc) {
                const bf16x8_t ga = *(const LAS bf16x8_t*)(Gs + (mt * 16 + c16) * GS_STRIDE + 32 * ks + 8 * g4);
                acc[mt][0] = MFMA16(w0, ga, acc[mt][0]); acc[mt][1] = MFMA16(w1, ga, acc[mt][1]);
            }
        }
        f32x4 o[4][2];
#pragma unroll
        for (int mt = 0; mt < 4; ++mt) { o[mt][0] = (f32x4){0.f, 0.f, 0.f, 0.f}; o[mt][1] = o[mt][0]; }
#pragma unroll
        for (int nt = 0; nt < 2; ++nt) {
            const f32x4 bias = *(const GAS f32x4*)(IN[19] + L * 256 + n0 + 16 * nt + 4 * g4);
#pragma unroll
            for (int mt = 0; mt < 4; ++mt) if (mt < nsc) {
                const v2u gw = *(const LAS v2u*)(Gs + (mt * 16 + c16) * GS_STRIDE + n0 + 16 * nt + 4 * g4);
                const f32x4 gv = (f32x4){bflo(gw.x), bfhi(gw.x), bflo(gw.y), bfhi(gw.y)};
                const f32x4 z = acc[mt][nt] + bias;
                o[mt][nt] = (f32x4){gv.x * sigmoidf_(z.x), gv.y * sigmoidf_(z.y), gv.z * sigmoidf_(z.z), gv.w * sigmoidf_(z.w)};
            }
        }
        rms_store_tile(F, o, base, 512, n0, nsc);
    }
    __syncthreads();
}

__device__ __forceinline__ void pool_unit(Frame& F, int L, int unit) {
    const kin_t IN = kin();
    const int lane = F.lane, c16 = lane & 15, g4 = lane >> 4;
    const float* Up = (const float*)(F.wl + WS_UPL);
    LAS bf16* Ps = (LAS bf16*)(F.lds + SM_G_OFF);
    const bool samp = unit >= 256; const int base = unit * 64, nsc = 4;
    {
        const int ch = F.tid & 255, half = F.tid >> 8, gi = ch >> 6;
        for (int q = 0; q < nsc; ++q) {
            const int lr0 = half * (nsc * 8) + q * 8, r0 = base + lr0;
            float v[23];
            int t0;
            if (!samp) { t0 = r0 & (SEQ - 1);
#pragma unroll
                for (int i = 0; i < 15; ++i) v[i] = (t0 - 15 + i >= 0) ? Up[(size_t)(r0 - 15 + i) * 256 + ch] : 0.f; }
            else { t0 = 0; const int bs = (r0 - MP) >> 3;
#pragma unroll
                for (int i = 0; i < 15; ++i) v[i] = IN[6][((size_t)(L * 32 + bs) * 15 + i) * 256 + ch]; }
#pragma unroll
            for (int i = 0; i < 8; ++i) v[15 + i] = Up[(size_t)(r0 + i) * 256 + ch];
            float cs[24]; cs[0] = 0.f;
#pragma unroll
            for (int i = 0; i < 23; ++i) cs[i + 1] = cs[i] + v[i];
            float r[8];
#pragma unroll
            for (int tau = 0; tau < 8; ++tau) {
                const float lo = gi == 0 ? cs[14 + tau] : (gi == 1 ? cs[12 + tau] : (gi == 2 ? cs[8 + tau] : cs[tau]));
                const int w = 2 << gi, t = t0 + tau; const float cnt = samp ? (float)w : (float)((t + 1 < w) ? t + 1 : w);
                r[tau] = (cs[16 + tau] - lo) / cnt - v[15 + tau];
            }
#pragma unroll
            for (int i = 0; i < 8; ++i) Ps[(lr0 + i) * GS_STRIDE + ch] = (bf16)f2bf(r[i]);
        }
    }
    __syncthreads();
    {
        const int gi = F.wave >> 1, d0 = 32 * (F.wave & 1), n0 = 64 * gi + d0;
        const bf16* Wt = (const bf16*)(F.ws + WS_PW) + (size_t)(L * 4 + gi) * 4096;
        f32x4 acc[4][2];
#pragma unroll
        for (int mt = 0; mt < 4; ++mt) { acc[mt][0] = (f32x4){0.f, 0.f, 0.f, 0.f}; acc[mt][1] = acc[mt][0]; }
#pragma unroll
        for (int ks = 0; ks < 2; ++ks) {
            const bf16x8_t w0 = *(const GAS bf16x8_t*)(Wt + (size_t)(d0 + c16) * 64 + 32 * ks + 8 * g4), w1 = *(const GAS bf16x8_t*)(Wt + (size_t)(d0 + 16 + c16) * 64 + 32 * ks + 8 * g4);
#pragma unroll
            for (int mt = 0; mt < 4; ++mt) if (mt < nsc) {
                const bf16x8_t pa = *(const LAS bf16x8_t*)(Ps + (mt * 16 + c16) * GS_STRIDE + 64 * gi + 32 * ks + 8 * g4);
                acc[mt][0] = MFMA16(w0, pa, acc[mt][0]); acc[mt][1] = MFMA16(w1, pa, acc[mt][1]);
            }
        }
        f32x4 o[4][2];
#pragma unroll
        for (int nt = 0; nt < 2; ++nt) {
            const f32x4 scl = *(const GAS f32x4*)(IN[21] + L * 256 + n0 + 16 * nt + 4 * g4);
#pragma unroll
            for (int mt = 0; mt < 4; ++mt) o[mt][nt] = acc[mt][nt] * scl;
        }
        rms_store_tile(F, o, base, 768, n0, nsc);
    }
    __syncthreads();
}

constexpr int AV_STRIDE = 160;
constexpr int AV_TILE = 32 * AV_STRIDE;
constexpr int AT_RED_OFF = 0, AT_V_OFF = 4096;
struct AStep { int sig, q, dmax, par, n0; };
__device__ __forceinline__ AStep astep(int s) {
    AStep a;
    if (s < 9) { a.sig = 8; a.q = 1; a.dmax = 256; a.par = 1; a.n0 = 16 - 32 * (9 - s); }
    else if (s < 14) { a.sig = 4; a.q = 2; a.dmax = 128; a.par = 0; a.n0 = 31 - 32 * (14 - s); }
    else { a.sig = 1; a.q = 8; a.dmax = 128; a.par = 0; a.n0 = 121 - 32 * (22 - s); }
    return a;
}
struct AFrag { bf16x8_t kA0, kA1, kB0, kB1; v4u v[4]; };
__device__ __forceinline__ void attn_load(AFrag& f, const bf16* Kh, const bf16* Vh, int RB, int tb  , const AStep& a, int lane) {
    const int c16 = lane & 15, g = lane >> 4;
    int pA = tb + a.sig * (a.n0 + c16), pB = pA + 16 * a.sig; pA = pA < 0 ? 0 : pA; pB = pB < 0 ? 0 : pB;
    const bf16* ka = Kh + (size_t)(RB + pA) * 512 + 8 * g; const bf16* kb = Kh + (size_t)(RB + pB) * 512 + 8 * g;
    f.kA0 = *(const GAS bf16x8_t*)ka; f.kA1 = *(const GAS bf16x8_t*)(ka + 32); f.kB0 = *(const GAS bf16x8_t*)kb; f.kB1 = *(const GAS bf16x8_t*)(kb + 32);
#pragma unroll
    for (int c = 0; c < 4; ++c) { int pv = tb + a.sig * (a.n0 + (lane >> 3) + 8 * c); pv = pv < 0 ? 0 : pv; f.v[c] = *(const GAS v4u*)(Vh + (size_t)(RB + pv) * 512 + 8 * (lane & 7)); }
}
__device__ __forceinline__ void attn_mfma_unit(Frame& F, int unit, int r0) {
    const int lane = F.lane, c16 = lane & 15, g = lane >> 4, h = F.wave;
    const int b = unit >> 6, T0 = (unit & 63) * 128, RB = b * SEQ;
    const bf16* Qh = (const bf16*)(F.wl + WS_QB) + h * 64; const bf16* Kh = (const bf16*)(F.wl + WS_KB) + h * 64; const bf16* Vh = (const bf16*)(F.wl + WS_VB) + h * 64;
    LAS unsigned char* vt = F.lds + AT_V_OFF + h * (2 * AV_TILE);
    LAS float* red = (LAS float*)(F.lds + AT_RED_OFF);
    const int vw_off = (lane >> 3) * AV_STRIDE + (lane & 7) * 16;
    const int vr_off = (4 * g + (c16 >> 2)) * AV_STRIDE + (c16 & 3) * 8;
    for (int r = r0; r < r0 + 1; ++r) {
        const int tb = T0 + r, qrow = RB + tb + 8 * c16;
        const bf16x8_t q0 = *(const GAS bf16x8_t*)(Qh + (size_t)qrow * 512 + 8 * g), q1 = *(const GAS bf16x8_t*)(Qh + (size_t)qrow * 512 + 32 + 8 * g);
        float m = -1e30f, l = 0.f;
        f32x4 acc[4];
#pragma unroll
        for (int d = 0; d < 4; ++d) acc[d] = (f32x4){0.f, 0.f, 0.f, 0.f};
        AFrag cur; attn_load(cur, Kh, Vh, RB, tb, astep(0), lane);
#pragma unroll
        for (int c = 0; c < 4; ++c) *(LAS v4u*)(vt + vw_off + c * 8 * AV_STRIDE) = cur.v[c];
        for (int s = 0; s < 22; ++s) {
            const AStep a = astep(s);
            AFrag nxt;
            if (s + 1 < 22) attn_load(nxt, Kh, Vh, RB, tb, astep(s + 1), lane);
            LAS unsigned char* vb = vt + (s & 1) * AV_TILE;
            f32x4 sA = (f32x4){0.f, 0.f, 0.f, 0.f}, sB = sA;
            sA = __builtin_amdgcn_mfma_f32_16x16x32_bf16(cur.kA0, q0, sA, 0, 0, 0); sA = __builtin_amdgcn_mfma_f32_16x16x32_bf16(cur.kA1, q1, sA, 0, 0, 0);
            sB = __builtin_amdgcn_mfma_f32_16x16x32_bf16(cur.kB0, q0, sB, 0, 0, 0); sB = __builtin_amdgcn_mfma_f32_16x16x32_bf16(cur.kB1, q1, sB, 0, 0, 0);
            const int hi = a.q * c16; int lo = hi - a.dmax;
            { const int nmin = -(tb / a.sig); lo = lo > nmin ? lo : nmin; }
            const int nb = a.n0 + 4 * g;
            float mx = -1e30f;
#pragma unroll
            for (int e = 0; e < 4; ++e) {
                const int nA = nb + e, nB = nA + 16;
                bool vA = nA >= lo && nA <= hi, vB = nB >= lo && nB <= hi;
                if (a.par) { const bool pe = ((nA ^ c16) & 1) == 0; vA = vA && pe; vB = vB && pe; }
                sA[e] = vA ? sA[e] : -1e30f; sB[e] = vB ? sB[e] : -1e30f;
                mx = fmaxf(mx, fmaxf(sA[e], sB[e]));
            }
            mx = fmaxf(mx, __shfl_xor(mx, 16)); mx = fmaxf(mx, __shfl_xor(mx, 32));
            const float mn = fmaxf(m, mx), scl = __builtin_amdgcn_exp2f(m - mn); m = mn;
            float ps = 0.f;
#pragma unroll
            for (int e = 0; e < 4; ++e) { sA[e] = __builtin_amdgcn_exp2f(sA[e] - mn); sB[e] = __builtin_amdgcn_exp2f(sB[e] - mn); ps += sA[e] + sB[e]; }
            l = l * scl + ps;
#pragma unroll
            for (int d = 0; d < 4; ++d) acc[d] = acc[d] * scl;
            v4u pw; pw.x = pk2(sA[0], sA[1]); pw.y = pk2(sA[2], sA[3]); pw.z = pk2(sB[0], sB[1]); pw.w = pk2(sB[2], sB[3]);
            const bf16x8_t pb = __builtin_bit_cast(bf16x8_t, pw);
#pragma unroll
            for (int d = 0; d < 4; ++d) {
                const s16x4_t v0 = __builtin_bit_cast(s16x4_t, __builtin_amdgcn_ds_read_tr16_b64_v4i16((LAS s16x4_t*)(vb + vr_off + d * 32)));
                const s16x4_t v1 = __builtin_bit_cast(s16x4_t, __builtin_amdgcn_ds_read_tr16_b64_v4i16((LAS s16x4_t*)(vb + vr_off + 16 * AV_STRIDE + d * 32)));
                const bf16x8_t vf = (bf16x8_t){v0[0], v0[1], v0[2], v0[3], v1[0], v1[1], v1[2], v1[3]};
                acc[d] = __builtin_amdgcn_mfma_f32_16x16x32_bf16(vf, pb, acc[d], 0, 0, 0);
            }
            if (s + 1 < 22) {
                LAS unsigned char* vn = vt + ((s + 1) & 1) * AV_TILE;
#pragma unroll
                for (int c = 0; c < 4; ++c) *(LAS v4u*)(vn + vw_off + c * 8 * AV_STRIDE) = nxt.v[c];
                cur = nxt;
            }
        }
        l += __shfl_xor(l, 16); l += __shfl_xor(l, 32);
        const float rl = 1.0f / l;
        float ss = 0.f;
#pragma unroll
        for (int d = 0; d < 4; ++d) { acc[d] = acc[d] * rl; ss += (acc[d].x * acc[d].x + acc[d].y * acc[d].y) + (acc[d].z * acc[d].z + acc[d].w * acc[d].w); }
        ss += __shfl_xor(ss, 16); ss += __shfl_xor(ss, 32);
        LAS float* rd = red + (r & 1) * 128 + c16 * 8;
        if (g == 0) rd[h] = ss;
        __syncthreads();
        float tot = 0.f;
#pragma unroll
        for (int w = 0; w < 8; ++w) tot += rd[w];
        const float rstd = rsqrtf(tot * (1.0f / 512.0f) + EPS);
        bf16* mp = (bf16*)(F.wl + WS_MIX) + (size_t)qrow * DM + h * 64 + 4 * g;
#pragma unroll
        for (int d = 0; d < 4; ++d) st_bf4(mp + 16 * d, acc[d] * rstd);
    }
    __syncthreads();
}

constexpr int U_PER = 256, U_SMP = 4;
__device__ __forceinline__ void mix_unit(Frame& F, int L, int type, int idx) {
    { int t_ = threadIdx.x; asm volatile("" : "+v"(t_)); F.tid = t_; F.lane = t_ & 63; F.wave = __builtin_amdgcn_readfirstlane(t_ >> 6);
      const kin_t ka = kin(); F.out = (float*)ka[32]; F.ws = (unsigned char*)ka[33]; F.wl = layer_base(F.ws, L); }
    const int xl = idx & 7, xj = idx >> 3;
    if (type == 0) {
        const bool heavy = idx < 8 && !(idx & 1);
        const int nt = heavy ? 1 : 4;
        for (int k = 0; k < nt; ++k) attn_mfma_unit(F, 16 * xl + (xj >> 1), 4 * (xj & 1) + k);
        if (idx >= 8 && idx < 20) { const int hx = idx - 8, src = 2 * (hx / 3), k = 1 + hx % 3;
            attn_mfma_unit(F, 16 * src, k); }
    }
    else if (type == 1) {
        float o[16];
        const int sr = (4 * xl + (xj >> 3)) * 8 + (xj & 7);
        attn_row<true>(F, L, MP + sr, sr >> 3, sr & 7, F.wave, o);
        attn_store(F, MP + sr, F.wave, o, 0);
        __syncthreads();
    } else if (type == 2) ssm_unit(F, L, idx);
    else pool_unit(F, L, idx);
}
__device__ __forceinline__ void ph_mix(Frame& F, int L, int ptype, int pn) {
    for (int c = F.bx; c < U_PER; c += F.G)
        for (int i = 0; i < 4; ++i) {
            const int type = i, reps = (type == ptype) ? pn : 1;
            for (int rep = 0; rep < reps; ++rep) mix_unit(F, L, type, c);
        }
    for (int e = F.bx; e < 2 * U_SMP; e += F.G) {
        const int type = 2 + (e & 1), reps = (type == ptype) ? pn : 1;
        for (int rep = 0; rep < reps; ++rep) mix_unit(F, L, type, 256 + (e >> 1));
    }
}

__device__ __forceinline__ void ph_convfix(Frame& F, int L) {
    const kin_t IN = kin();
    const float* halo = (const float*)(F.wl + WS_HALO); bf16* Act = (bf16*)(F.wl + WS_ACT);
    const float* cw = IN[28] + (size_t)L * 3 * DUP; const float* cb = IN[29] + (size_t)L * DUP;
    constexpr int CQ = DFF / 4, NIT = 256 * 2 * CQ;
    for (int it = F.bx * 512 + F.tid; it < NIT; it += F.G * 512) {
        const int c0 = (it % CQ) * 4, hr = (it / CQ) & 1, seg = it / (2 * CQ);
        const int pc = 256 * (c0 / 128) + (c0 % 128);
        const bool first = (seg & 127) == 0;
        const f32x4 z = (f32x4){0.f, 0.f, 0.f, 0.f};
        const float* hc = halo + (size_t)seg * 4 * DUP; const float* hp = hc - 4 * DUP;
        const f32x4 xa = *(const GAS f32x4*)(hc + hr * DUP + pc), xg = *(const GAS f32x4*)(hc + hr * DUP + pc + 128);
        f32x4 a1, g1, a2, g2;
        if (hr == 0) { a1 = first ? z : *(const GAS f32x4*)(hp + 3 * DUP + pc); g1 = first ? z : *(const GAS f32x4*)(hp + 3 * DUP + pc + 128);
                       a2 = first ? z : *(const GAS f32x4*)(hp + 2 * DUP + pc); g2 = first ? z : *(const GAS f32x4*)(hp + 2 * DUP + pc + 128); }
        else { a1 = *(const GAS f32x4*)(hc + pc); g1 = *(const GAS f32x4*)(hc + pc + 128);
               a2 = first ? z : *(const GAS f32x4*)(hp + 3 * DUP + pc); g2 = first ? z : *(const GAS f32x4*)(hp + 3 * DUP + pc + 128); }
        const int ca = c0, cg = DFF + c0;
        const f32x4 av = *(const GAS f32x4*)(cb + ca) + a2 * *(const GAS f32x4*)(cw + ca) + a1 * *(const GAS f32x4*)(cw + DUP + ca) + xa * *(const GAS f32x4*)(cw + 2 * DUP + ca);
        const f32x4 gv = *(const GAS f32x4*)(cb + cg) + g2 * *(const GAS f32x4*)(cw + cg) + g1 * *(const GAS f32x4*)(cw + DUP + cg) + xg * *(const GAS f32x4*)(cw + 2 * DUP + cg);
        st_bf4(Act + (size_t)(seg * 64 + hr) * DFF + c0, silu_gate4(gv, av));
    }
}


constexpr int SG_STRIDE = 68;
template <int MODE>
__device__ __forceinline__ void sgemm_sample(Frame& F, int L, const bf16* A  , const bf16* Bt  , int N, int K,
                                             const float* xs  , int xin_off, int xf_off, int xb_off, int rs_off  ) {
    const int lane = F.lane, c16 = lane & 15, g4 = lane >> 4;
    LAS float* part = (LAS float*)F.lds;
    const int ntile = 8 * (N / 64), kw = K / 8, ksteps = kw / 32, k0 = F.wave * kw;
    for (int tile = F.bx; tile < ntile; tile += F.G) {
        const int tm = tile & 7, tn = tile >> 3;
        f32x4 acc[2][4];
#pragma unroll
        for (int mi = 0; mi < 2; ++mi)
#pragma unroll
            for (int ni = 0; ni < 4; ++ni) acc[mi][ni] = (f32x4){0.f, 0.f, 0.f, 0.f};
        const bf16* ap = A + (size_t)(tm * 32 + c16) * K + k0 + 8 * g4;
        const bf16* bp = Bt + (size_t)(tn * 64 + c16) * K + k0 + 8 * g4;
#pragma unroll 4
        for (int ks = 0; ks < ksteps; ++ks) {
            bf16x8_t a[2], b[4];
#pragma unroll
            for (int mi = 0; mi < 2; ++mi) a[mi] = *(const GAS bf16x8_t*)(ap + (size_t)(mi * 16) * K + ks * 32);
#pragma unroll
            for (int ni = 0; ni < 4; ++ni) b[ni] = *(const GAS bf16x8_t*)(bp + (size_t)(ni * 16) * K + ks * 32);
#pragma unroll
            for (int mi = 0; mi < 2; ++mi)
#pragma unroll
                for (int ni = 0; ni < 4; ++ni) acc[mi][ni] = MFMA16(b[ni], a[mi], acc[mi][ni]);
        }
#pragma unroll
        for (int mi = 0; mi < 2; ++mi)
#pragma unroll
            for (int ni = 0; ni < 4; ++ni) *(LAS f32x4*)(part + (F.wave * 32 + mi * 16 + c16) * SG_STRIDE + ni * 16 + 4 * g4) = acc[mi][ni];
        __syncthreads();
        {
            const int r = F.tid >> 4, c4 = (F.tid & 15) * 4;
            f32x4 v = *(const LAS f32x4*)(part + r * SG_STRIDE + c4);
#pragma unroll
            for (int w = 1; w < 8; ++w) v = v + *(const LAS f32x4*)(part + (w * 32 + r) * SG_STRIDE + c4);
            const int row = MP + tm * 32 + r, col = tn * 64 + c4;
            if (MODE == 0) {
                const Epi1Ptrs P = epi1_ptrs(F.ws, F.out, L);
                const float rstd = rstd_from_partials(P.rs, row, 1.0f / 1024.0f);
                epi1_store(P, row, col >> 8, col & 255, v * rstd);
            } else {
                const float* Xin = (const float*)(F.ws + xin_off); float* Xf = (float*)(F.ws + xf_off); bf16* Xb = (bf16*)(F.ws + xb_off); float* rso = (float*)(F.ws + rs_off);
                const float* brow = xs ? xs + (size_t)(row - MP) * DM : Xin + (size_t)row * DM;
                v = v + *(const GAS f32x4*)(brow + col);
                *(GAS f32x4*)(Xf + (size_t)row * DM + col) = v;
                st_bf4(Xb + (size_t)row * DM + col, v);
                float ss = (v.x * v.x + v.y * v.y) + (v.z * v.z + v.w * v.w);
                ss += __shfl_xor(ss, 1); ss += __shfl_xor(ss, 2); ss += __shfl_xor(ss, 4); ss += __shfl_xor(ss, 8);
                if ((F.tid & 15) == 0) rso[(size_t)tn * MT + row] = ss;
            }
        }
        __syncthreads();
    }
}


__device__ __forceinline__ void l2_sweep(Frame& F, int which) {
    const kin_t INx = kin(); const GAS f32x4* src = (const GAS f32x4*)INx[2] + (size_t)which * (256 * 16384) + (size_t)F.bx * 16384 + F.tid;
    f32x4 s = (f32x4){0.f, 0.f, 0.f, 0.f};
#pragma unroll 8
    for (int i = 0; i < 32; ++i) s = s + src[(size_t)i * 512];
    if (s.x + s.y + s.z + s.w == 12345.678f) F.out[0] = s.x;
}

__device__ __forceinline__ void ph_final(Frame& F) {
    const kin_t IN = kin();
    const float* Xf = (const float*)(F.ws + WS_XFV0 + 3 * XF_VSTRIDE); const float* rs1 = (const float*)(F.ws + WS_RS1V0 + 2 * RS_VSTRIDE); const float* gf = IN[31];
    const int wv = (F.bx >> 3) * 8 + F.wave, nrow = (F.G == 256 && F.bx < 32) ? 9 : 8;
    for (int i = 0; i < nrow; ++i) {
        const int m = F.G == 256 ? (i < 8 ? 2048 * (F.bx & 7) + wv + 256 * i : MP + F.bx * 8 + F.wave) : 0;
        const float rstd = rstd_from_partials(rs1, m, 1.0f / 1024.0f);
        const GAS f32x4* xr = (const GAS f32x4*)(Xf + (size_t)m * DM) + F.lane; const GAS f32x4* gr = (const GAS f32x4*)gf + F.lane;
        GAS f32x4* orow = (GAS f32x4*)(F.out + (m < MP ? O_YP + (size_t)m * DM : O_YS + (size_t)(m - MP) * DM)) + F.lane;
#pragma unroll
        for (int j = 0; j < 4; ++j) orow[64 * j] = xr[64 * j] * rstd * gr[64 * j];
    }
}

namespace cg = cooperative_groups;
constexpr int LDSCTL_OFF = 131072, MISC_OFF = LDSCTL_OFF + 320;
constexpr int CW_BAR = 4096;
constexpr int N_PHASES = 16;
__global__ void __launch_bounds__(512, 2) fwd_kernel(Args args) {
    extern __shared__ __attribute__((aligned(16))) unsigned char lds[];
    Frame F;
    F.lds = (LAS unsigned char*)lds; F.G = gridDim.x;
    for (int u = threadIdx.x; u < (LDS_BYTES - LDSCTL_OFF) / 4; u += 512) ((LAS unsigned*)(F.lds + LDSCTL_OFF))[u] = 0u;
    __syncthreads();
    const bool fused = (args.ph_hi - args.ph_lo) > 1;
    XcdBarrier bar; bar.bar = (unsigned*)(args.ws + WS_CTL) + CW_BAR; bar.x = 0; bar.st = nullptr;
    if (fused) bar = xcd_barrier_post((unsigned*)(args.ws + WS_CTL) + CW_BAR, (volatile LAS unsigned*)(F.lds + MISC_OFF) + 8);
    for (int ph = args.ph_lo; ph < args.ph_hi; ++ph) {
#ifndef PHM
#define PHM 0xFFFF
#endif
        const int L = (ph - 1) / 7, sub = (ph == 0 || ph == 15) ? -1 : (ph - 1) % 7;
        const int nrep = (args.probe_n > 1 && (sub == args.probe_sub || (ph == 0 && args.probe_sub == 7) || (ph == 15 && args.probe_sub == 8))) ? args.probe_n : 1;
        for (int rep = 0; rep < nrep; ++rep) {
        {
            int t_ = threadIdx.x; asm volatile("" : "+v"(t_));
            F.tid = t_; F.lane = t_ & 63; F.wave = __builtin_amdgcn_readfirstlane(t_ >> 6);
            int bx_ = blockIdx.x; asm volatile("" : "+s"(bx_)); F.bx = bx_;
            const kin_t ka = kin(); F.out = (float*)ka[32]; F.ws = (unsigned char*)ka[33];
        }
        unsigned char* ws = F.ws;
        F.wl = layer_base(ws, L < 0 ? 0 : (L > 1 ? 1 : L)); unsigned char* wl = F.wl;
        if (ph == 0) { ph_prologue(F); l2_sweep(F, 0); }
        else if (ph == 15) { ph_final(F); }
        else if (sub == 0) {
            const bf16* Xin = (const bf16*)(ws + WS_XBV0 + (size_t)(2 * L) * XB_VSTRIDE);
            pg8::Gemm g{Xin, (const bf16*)(ws + WS_WIN) + (size_t)L * DIN * DM, MP, DIN, DM}; pg8::StaticOrder S; S.init(MP, DIN, F.G, F.bx);
            Epi1 E{ws, F.out, L};
            pg8::gemm_phase<Epi1, pg8::StaticOrder, true, true>(F.lds, g, S, E);
            sgemm_sample<0>(F, L, Xin + (size_t)MP * DM, (const bf16*)(ws + WS_WIN) + (size_t)L * DIN * DM, DIN, DM, nullptr, 0, 0, 0, 0);
        } else if (sub == 1) { ph_ssm1(F, L); }
        else if (sub == 2) { ph_mix(F, L, args.probe_sub - 10, args.probe_n); }
        else if (sub == 3) {
            const kin_t IN = kin();
            const int xin = (int)(WS_XFV0 + 1 * XF_VSTRIDE), xf = (int)(WS_XFV0 + (size_t)(2 * L) * XF_VSTRIDE), xb = (int)(WS_XBV0 + (size_t)(1 + 2 * L) * XB_VSTRIDE), rs = (int)(WS_LAYER0 + (size_t)L * LSTRIDE + WS_RS2);
            pg8::Gemm g{(const bf16*)(wl + WS_MIX), (const bf16*)(ws + WS_WOUT) + (size_t)L * DM * DM, MP, DM, DM}; pg8::StaticOrder S; S.init(MP, DM, F.G, F.bx);
            EpiRes E{ws, L == 0 ? IN[0] : nullptr, L == 0 ? IN[1] : nullptr, xin, xf, xb, rs};
            pg8::gemm_phase<EpiRes, pg8::StaticOrder, true, true>(F.lds, g, S, E);
            sgemm_sample<1>(F, L, (const bf16*)(wl + WS_MIX) + (size_t)MP * DM, (const bf16*)(ws + WS_WOUT) + (size_t)L * DM * DM, DM, DM, L == 0 ? IN[1] : nullptr, xin, xf, xb, rs);
        } else if (sub == 6) {
            const int xin = (int)(WS_XFV0 + (size_t)(2 * L) * XF_VSTRIDE), xf = (int)(WS_XFV0 + (size_t)(2 * L + 1) * XF_VSTRIDE), xb = (int)(WS_XBV0 + (size_t)(2 + 2 * L) * XB_VSTRIDE), rs = (int)(WS_RS1V0 + (size_t)(1 + L) * RS_VSTRIDE);
            pg8::Gemm g{(const bf16*)(wl + WS_ACT), (const bf16*)(ws + WS_WDN) + (size_t)L * DM * DFF, MP, DM, DFF}; pg8::StaticOrder S; S.init(MP, DM, F.G, F.bx);
            EpiRes E{ws, nullptr, nullptr, xin, xf, xb, rs};
            pg8::gemm_phase<EpiRes, pg8::StaticOrder, true, true>(F.lds, g, S, E);
            sgemm_sample<1>(F, L, (const bf16*)(wl + WS_ACT) + (size_t)MP * DFF, (const bf16*)(ws + WS_WDN) + (size_t)L * DM * DFF, DM, DFF, nullptr, xin, xf, xb, rs);
            if (L == 0) l2_sweep(F, 1);
        } else if (sub == 4) {
            const bf16* Xin = (const bf16*)(ws + WS_XBV0 + (size_t)(1 + 2 * L) * XB_VSTRIDE);
            pg8::Gemm g{Xin, (const bf16*)(ws + WS_WUP) + (size_t)L * DUP * DM, MT, DUP, DM}; pg8::StaticOrder S; S.init(MT, DUP, F.G, F.bx);
            const kin_t IN = kin();
            Epi3 E{ws, F.out, L, IN[28] + (size_t)L * 3 * DUP, IN[29] + (size_t)L * DUP, IN[7] + (size_t)L * 32 * 2 * DUP};
            pg8::gemm_phase<Epi3, pg8::StaticOrder, true, true>(F.lds, g, S, E);
        } else if (sub == 5) { ph_convfix(F, L); }
        if (rep + 1 < nrep) __syncthreads();
        }
        if (ph + 1 < args.ph_hi) {
            if (ph == 0) cg::this_grid().sync(); else xcd_barrier(bar);
        }
    }
}

#ifndef PROBE_SUB
#define PROBE_SUB 0
#define PROBE_N 1
#endif
#ifndef N_LAUNCHES
#define N_LAUNCHES 1
#endif
extern "C" void kernel_launch(void* const* d_in, const int* in_sizes, int n_in, void* d_out, int out_size, void* d_ws, size_t ws_size, hipStream_t stream) {
    static int grid = 0;
    if (grid == 0) {
        if (n_in != 32 || out_size != (int)O_END || ws_size < WS_END) { fprintf(stderr, "kernel_launch: unexpected shapes (n_in %d out %d ws %zu)\n", n_in, out_size, ws_size); grid = -1; return; }
        int dev = 0, cus = 0, per_cu = 0;
        if (hipGetDevice(&dev) != hipSuccess || hipDeviceGetAttribute(&cus, hipDeviceAttributeMultiprocessorCount, dev) != hipSuccess) { grid = -1; return; }
        if (hipFuncSetAttribute((const void*)fwd_kernel, hipFuncAttributeMaxDynamicSharedMemorySize, LDS_BYTES) != hipSuccess) { fprintf(stderr, "hipFuncSetAttribute failed\n"); grid = -1; return; }
        if (hipOccupancyMaxActiveBlocksPerMultiprocessor(&per_cu, (const void*)fwd_kernel, 512, LDS_BYTES) != hipSuccess || per_cu < 1) { fprintf(stderr, "occupancy query failed (%d)\n", per_cu); (void)hipGetLastError(); grid = -1; return; }
        grid = cus;
    }
    if (grid < 0) return;
    Args a{};
    for (int i = 0; i < 32; ++i) a.in[i] = (const float*)d_in[i];
    a.out = (float*)d_out; a.ws = (unsigned char*)d_ws; a.probe_sub = PROBE_SUB; a.probe_n = PROBE_N;
    if (N_LAUNCHES == 1) {
        if (hipMemsetAsync((char*)d_ws + WS_CTL, 0, CTL_ZERO_BYTES, stream) != hipSuccess) { fprintf(stderr, "memset failed\n"); return; }
        a.ph_lo = 0; a.ph_hi = N_PHASES;
        void* kargs[] = {&a};
        const hipError_t e = hipLaunchCooperativeKernel((const void*)fwd_kernel, dim3(grid), dim3(512), kargs, LDS_BYTES, stream);
        if (e != hipSuccess) fprintf(stderr, "cooperative launch failed: %s (grid %d)\n", hipGetErrorString(e), grid);
    } else {
        for (int ph = 0; ph < N_PHASES; ++ph) {
            a.ph_lo = ph; a.ph_hi = ph + 1;
            hipLaunchKernelGGL(fwd_kernel, dim3(grid), dim3(512), LDS_BYTES, stream, a);
        }
    }
}
```

```cpp
#include <hip/hip_runtime.h>
#include <hip/hip_cooperative_groups.h>
#include <cstdio>
#include <cstdint>
namespace pg8 {
#define PG8_LAS __attribute__((address_space(3)))
typedef unsigned short bf16_t;
typedef short bf16x8 __attribute__((ext_vector_type(8)));
typedef float f32x4 __attribute__((ext_vector_type(4)));
typedef unsigned u32x4 __attribute__((ext_vector_type(4)));
constexpr int BM = 256, BK = 64, HALF = 128, HTB = HALF * BK * 2  , STAGE_BYTES = 8 * HTB, NXCD = 8, WGM = 8;

__host__ __device__ __forceinline__ int lds_byte(int r, int c) { const int st = (r >> 4) * 2 + (c >> 5), rr = r & 15, cc = c & 31, ob = rr * 64 + cc * 2; return st * 1024 + (ob ^ (((ob >> 9) & 1) << 5)); }
__host__ __device__ __forceinline__ void stage_rc(int b, int& R, int& C) { const int st = b / 1024, sb = b % 1024, swz = sb ^ (((sb >> 9) & 1) << 5); R = (st >> 1) * 16 + swz / 64; C = (st & 1) * 32 + (swz % 64) / 2; }
__host__ __device__ __forceinline__ int perm32(int rho) { const int n = rho >> 4, i = rho & 15; return 8 * (i >> 2) + 4 * n + (i & 3); }

struct Unit { int pm, pn; };
struct Gemm { const bf16_t* A; const bf16_t* Bt; int M, N, K; };

struct StaticOrder {
    int nM, nN, nwg, G, c;
    __host__ __device__ void init(int M, int N, int G_, int c_) { nM = M / BM; nN = N / BM; nwg = nM * nN; G = G_; c = c_; }
    __host__ __device__ bool next(int i, Unit& u) const {
        const long L = (long)i * G + c; if (L >= nwg) return false;
        int wgid = (int)L; { const int q = nwg / NXCD, r = nwg % NXCD, xcd = wgid % NXCD, off = wgid / NXCD; wgid = (xcd < r ? xcd * (q + 1) : r * (q + 1) + (xcd - r) * q) + off; }
        const int nig = WGM * nN, gid = wgid / nig, fm = gid * WGM, gsz = (nM - fm) < WGM ? (nM - fm) : WGM;
        u.pm = fm + ((wgid % nig) % gsz); u.pn = (wgid % nig) / gsz; return true;
    }
    __device__ __forceinline__ void a_ready(const Unit&) const {}
    __device__ __forceinline__ void done(const Unit&) const {}
};

__device__ __forceinline__ unsigned cvt_pk_bf16(float lo, float hi) { unsigned r; asm volatile("v_cvt_pk_bf16_f32 %0, %1, %2" : "=v"(r) : "v"(lo), "v"(hi)); return r; }
typedef float f32x2 __attribute__((ext_vector_type(2)));
__device__ __forceinline__ f32x2 gelu_pk(f32x2 v) {
    const f32x2 av = __builtin_elementwise_abs(v), d = av * 0.2316418882f + 1.0f;
    f32x2 t; t.x = __builtin_amdgcn_rcpf(d.x); t.y = __builtin_amdgcn_rcpf(d.y);
    f32x2 q = t * 0.5307027145f + (-0.7265760135f); q = q * t + 0.7107068705f; q = q * t + (-0.142248368f); q = q * t + 0.127414796f; q = q * t;
    const f32x2 s = (v * v) * (-0.72134752044f);
    f32x2 e; e.x = __builtin_amdgcn_exp2f(s.x); e.y = __builtin_amdgcn_exp2f(s.y);
    const f32x2 m = v * (q * e), r = v - m;
    f32x2 o; o.x = v.x < 0.f ? m.x : r.x; o.y = v.y < 0.f ? m.y : r.y; return o;
}

template <int ACT  > struct EpiBf16 {
    static constexpr bool PERM = true, AFTER_DRAIN = false; static_assert(ACT == 0 || ACT == 1, "EpiBf16: ACT is 0 (none) or 1 (gelu_pk)");
    bf16_t* O; int ldc; const float* bias; int split_cols; size_t split_stride; float scale0;
    __device__ __forceinline__ void operator()(const f32x4 (&acc)[2][2][4][2], const Unit& u, int wr, int wc, int fr, int fq) const {
        const int row0 = u.pm * BM + wr * 64 + fr; int colt = u.pn * BM; bf16_t* base = O;
        float sc = 1.f; if (split_cols) { const int t = colt / split_cols; base += (size_t)t * split_stride; colt -= t * split_cols; if (t == 0) sc = scale0; }
        const int col0 = colt + wc * 32 + 8 * fq, bcol0 = u.pn * BM + wc * 32 + 8 * fq;
        f32x4 bv[2][2];
#pragma unroll
        for (int bj = 0; bj < 2; ++bj)
#pragma unroll
            for (int n = 0; n < 2; ++n) bv[bj][n] = bias ? *(const f32x4*)(bias + bcol0 + bj * HALF + 4 * n) : (f32x4){0.f, 0.f, 0.f, 0.f};
#pragma unroll
        for (int ai = 0; ai < 2; ++ai)
#pragma unroll
            for (int m = 0; m < 4; ++m) { bf16_t* rowp = base + (size_t)(row0 + ai * HALF + m * 16) * ldc + col0;
#pragma unroll
                for (int bj = 0; bj < 2; ++bj) { f32x4 v0 = acc[ai][bj][m][0] + bv[bj][0], v1 = acc[ai][bj][m][1] + bv[bj][1];
                    if (ACT == 1) { f32x2 a = gelu_pk((f32x2){v0[0], v0[1]}), b = gelu_pk((f32x2){v0[2], v0[3]}), c = gelu_pk((f32x2){v1[0], v1[1]}), d = gelu_pk((f32x2){v1[2], v1[3]});
                        v0 = (f32x4){a.x, a.y, b.x, b.y}; v1 = (f32x4){c.x, c.y, d.x, d.y}; }
                    v0 = v0 * sc; v1 = v1 * sc; u32x4 w; w.x = cvt_pk_bf16(v0[0], v0[1]); w.y = cvt_pk_bf16(v0[2], v0[3]); w.z = cvt_pk_bf16(v1[0], v1[1]); w.w = cvt_pk_bf16(v1[2], v1[3]);
                    *(u32x4*)(rowp + bj * HALF) = w; } }
    }
};
template <class Epi, class Sched, bool ALIGN_EPI = false, bool SP2 = false>
__device__ __forceinline__ void gemm_phase(PG8_LAS unsigned char* lds, const Gemm g, const Sched& S, const Epi& E) {
    int tid_ = threadIdx.x; asm volatile("" : "+v"(tid_));
    const int tid = tid_, wid = __builtin_amdgcn_readfirstlane(tid >> 6), lane = tid & 63, wr = wid >> 2, wc = wid & 3, fr = lane & 15, fq = lane >> 4;
    const int K = g.K, nt = K / BK;
    unsigned voffA[2], voffB[2];
#pragma unroll
    for (int i = 0; i < 2; ++i) { int R, C; stage_rc(tid * 16 + i * 8192, R, C); const int Rb = Epi::PERM ? ((R & ~31) + perm32(R & 31)) : R;
        voffA[i] = (unsigned)(R * K + C) * 2u; voffB[i] = (unsigned)(Rb * K + C) * 2u; }
    const size_t kstep = (size_t)(BK * 2);
    const size_t hstep = (size_t)HALF * K * 2;
    const size_t tstep = 2 * hstep;
    const unsigned ldsw = (unsigned)wid * 1024u;
    const int aoff = lds_byte(wr * 64 + fr, fq * 8), boff = lds_byte(wc * 32 + fr, fq * 8);
#define PG8_SA(b, h) (((b) * 2 + (h)) * HTB)
#define PG8_SB(b, h) ((4 + (b) * 2 + (h)) * HTB)
#define PG8_STAGE(bufoff, gbase, voff) do { _Pragma("unroll") for (int _i = 0; _i < 2; ++_i) \
        __builtin_amdgcn_global_load_lds((const unsigned*)((const char*)(gbase) + (voff)[_i]), (PG8_LAS unsigned*)(lds + (bufoff) + ldsw + _i * 8192), 16, 0, 0); } while (0)
#define PG8_LDA(dst, b, h) do { _Pragma("unroll") for (int m = 0; m < 4; ++m) _Pragma("unroll") for (int k = 0; k < 2; ++k) dst[m][k] = *(const PG8_LAS bf16x8*)(lds + PG8_SA(b, h) + aoff + m * 2048 + k * 1024); } while (0)
#define PG8_LDB(dst, b, h) do { _Pragma("unroll") for (int n = 0; n < 2; ++n) _Pragma("unroll") for (int k = 0; k < 2; ++k) dst[n][k] = *(const PG8_LAS bf16x8*)(lds + PG8_SB(b, h) + boff + n * 2048 + k * 1024); } while (0)
#define PG8_MMA(ai, bj, At, Bt) do { __builtin_amdgcn_s_setprio(1); _Pragma("unroll") for (int m = 0; m < 4; ++m) _Pragma("unroll") for (int n = 0; n < 2; ++n) _Pragma("unroll") for (int k = 0; k < 2; ++k) \
        acc[ai][bj][m][n] = __builtin_amdgcn_mfma_f32_16x16x32_bf16(Bt[n][k], At[m][k], acc[ai][bj][m][n], 0, 0, 0); __builtin_amdgcn_s_setprio(0); } while (0)
#define PG8_WAIT_V(n) asm volatile("s_waitcnt vmcnt(" #n ")" ::: "memory")
#define PG8_WAIT_L(n) asm volatile("s_waitcnt lgkmcnt(" #n ")" ::: "memory")
#define PG8_BAR __builtin_amdgcn_s_barrier()
#define PG8_SCHED __builtin_amdgcn_sched_barrier(0)
    Unit cur, nxt; int ui = 0;
    if (!S.next(0, cur)) return;
    f32x4 acc[2][2][4][2];
#pragma unroll
    for (int a = 0; a < 2; ++a)
#pragma unroll
        for (int b = 0; b < 2; ++b)
#pragma unroll
            for (int m = 0; m < 4; ++m)
#pragma unroll
                for (int n = 0; n < 2; ++n) acc[a][b][m][n] = (f32x4){0.f, 0.f, 0.f, 0.f};
    bf16x8 At[4][2], B0[2][2], B1[2][2];
    const char* cA = (const char*)g.A + (size_t)cur.pm * tstep; const char* cB = (const char*)g.Bt + (size_t)cur.pn * tstep;
    S.a_ready(cur);
    if constexpr (SP2) {
        PG8_STAGE(PG8_SB(0, 0), cB, voffB); PG8_STAGE(PG8_SB(0, 1), cB + hstep, voffB); PG8_STAGE(PG8_SA(0, 0), cA, voffA); PG8_STAGE(PG8_SA(0, 1), cA + hstep, voffA);
        if (wr == 1) PG8_BAR;
        PG8_WAIT_V(2); PG8_BAR;
        PG8_STAGE(PG8_SB(1, 0), cB + kstep, voffB); PG8_STAGE(PG8_SA(1, 0), cA + kstep, voffA); PG8_STAGE(PG8_SB(1, 1), cB + hstep + kstep, voffB);
        PG8_WAIT_V(6); PG8_BAR;
    } else {
        PG8_STAGE(PG8_SB(0, 0), cB, voffB); PG8_STAGE(PG8_SA(0, 0), cA, voffA); PG8_STAGE(PG8_SB(0, 1), cB + hstep, voffB); PG8_STAGE(PG8_SA(0, 1), cA + hstep, voffA);
        if (wr == 1) PG8_BAR;
        PG8_WAIT_V(4); PG8_BAR;
        PG8_STAGE(PG8_SB(1, 0), cB + kstep, voffB); PG8_STAGE(PG8_SA(1, 0), cA + kstep, voffA); PG8_STAGE(PG8_SB(1, 1), cB + hstep + kstep, voffB);
        PG8_WAIT_V(6); PG8_BAR;
    }
    for (;;) {
        const bool has_next = S.next(ui + 1, nxt);
        const char* nA = has_next ? (const char*)g.A + (size_t)nxt.pm * tstep : cA; const char* nB = has_next ? (const char*)g.Bt + (size_t)nxt.pn * tstep : cB;
        for (int t = 0; t < nt; t += 2) {
            const bool last = (t == nt - 2);
            const char* a1 = cA + (size_t)(t + 1) * kstep;
            const char* a2 = last ? nA : cA + (size_t)(t + 2) * kstep; const char* b2 = last ? nB : cB + (size_t)(t + 2) * kstep;
            const char* a3 = a2 + kstep; const char* b3 = b2 + kstep;
            if (last && has_next) S.a_ready(nxt);
            if constexpr (SP2) {
            PG8_LDB(B0, 0, 0); PG8_LDB(B1, 0, 1); PG8_SCHED; PG8_LDA(At, 0, 0); PG8_STAGE(PG8_SA(1, 1), a1 + hstep, voffA);
            PG8_WAIT_V(8); PG8_WAIT_L(0); PG8_BAR; PG8_MMA(0, 0, At, B0); PG8_MMA(0, 1, At, B1); PG8_BAR; PG8_SCHED;
            PG8_LDA(At, 0, 1); PG8_STAGE(PG8_SB(0, 0), b2, voffB); PG8_STAGE(PG8_SB(0, 1), b2 + hstep, voffB); PG8_STAGE(PG8_SA(0, 0), a2, voffA);
            PG8_WAIT_V(8); PG8_WAIT_L(0); PG8_BAR; PG8_MMA(1, 0, At, B0); PG8_MMA(1, 1, At, B1); PG8_BAR; PG8_SCHED;
            PG8_LDB(B0, 1, 0); PG8_LDB(B1, 1, 1); PG8_SCHED; PG8_LDA(At, 1, 0); PG8_STAGE(PG8_SA(0, 1), a2 + hstep, voffA);
            PG8_WAIT_V(8); PG8_WAIT_L(0); PG8_BAR; PG8_MMA(0, 0, At, B0); PG8_MMA(0, 1, At, B1); PG8_BAR; PG8_SCHED;
            PG8_LDA(At, 1, 1); PG8_STAGE(PG8_SB(1, 0), b3, voffB); PG8_STAGE(PG8_SB(1, 1), b3 + hstep, voffB); PG8_STAGE(PG8_SA(1, 0), a3, voffA);
            PG8_WAIT_V(8); PG8_WAIT_L(0); PG8_BAR; PG8_MMA(1, 0, At, B0); PG8_MMA(1, 1, At, B1); PG8_BAR; PG8_SCHED;
            } else {
            PG8_LDB(B0, 0, 0); PG8_SCHED; PG8_LDA(At, 0, 0); PG8_STAGE(PG8_SA(1, 1), a1 + hstep, voffA);
            PG8_WAIT_L(8); PG8_BAR; PG8_WAIT_L(0); PG8_MMA(0, 0, At, B0); PG8_BAR; PG8_SCHED;
            PG8_LDB(B1, 0, 1); PG8_STAGE(PG8_SB(0, 0), b2, voffB);
            PG8_BAR; PG8_WAIT_L(0); PG8_MMA(0, 1, At, B1); PG8_BAR;
            PG8_LDA(At, 0, 1); PG8_STAGE(PG8_SA(0, 0), a2, voffA);
            PG8_BAR; PG8_WAIT_L(0); PG8_MMA(1, 0, At, B0); PG8_BAR; PG8_SCHED;
            PG8_STAGE(PG8_SB(0, 1), b2 + hstep, voffB);
            PG8_WAIT_V(6); PG8_BAR; PG8_MMA(1, 1, At, B1); PG8_BAR;
            PG8_LDB(B0, 1, 0); PG8_SCHED; PG8_LDA(At, 1, 0); PG8_STAGE(PG8_SA(0, 1), a2 + hstep, voffA);
            PG8_WAIT_L(8); PG8_BAR; PG8_WAIT_L(0); PG8_MMA(0, 0, At, B0); PG8_BAR; PG8_SCHED;
            PG8_LDB(B1, 1, 1); PG8_STAGE(PG8_SB(1, 0), b3, voffB);
            PG8_BAR; PG8_WAIT_L(0); PG8_MMA(0, 1, At, B1); PG8_BAR;
            PG8_LDA(At, 1, 1); PG8_STAGE(PG8_SA(1, 0), a3, voffA);
            PG8_BAR; PG8_WAIT_L(0); PG8_MMA(1, 0, At, B0); PG8_BAR; PG8_SCHED;
            PG8_STAGE(PG8_SB(1, 1), b3 + hstep, voffB);
            PG8_WAIT_V(6); PG8_BAR; PG8_MMA(1, 1, At, B1); PG8_BAR;
            }
        }
        if constexpr (ALIGN_EPI) { if (wr == 0) PG8_BAR; }
        if constexpr (!Epi::AFTER_DRAIN) { E(acc, cur, wr, wc, fr, fq); S.done(cur); }
        if (!has_next) break;
#pragma unroll
        for (int a = 0; a < 2; ++a)
#pragma unroll
            for (int b = 0; b < 2; ++b)
#pragma unroll
                for (int m = 0; m < 4; ++m)
#pragma unroll
                    for (int n = 0; n < 2; ++n) acc[a][b][m][n] = (f32x4){0.f, 0.f, 0.f, 0.f};
        cur = nxt; cA = nA; cB = nB; ++ui;
        if constexpr (ALIGN_EPI) { if (wr == 1) PG8_BAR; }
    }
    PG8_WAIT_V(0);
    if constexpr (!ALIGN_EPI) { if (wr == 0) PG8_BAR; }
    PG8_BAR;
    if constexpr (Epi::AFTER_DRAIN) { E.fused(acc, cur, wr, wc, fr, fq, lds, wid, lane); S.done(cur); }
#undef PG8_SA
#undef PG8_SB
#undef PG8_STAGE
#undef PG8_LDA
#undef PG8_LDB
#undef PG8_MMA
#undef PG8_WAIT_V
#undef PG8_WAIT_L
#undef PG8_BAR
#undef PG8_SCHED
}
}

constexpr int DM = 1024, SEQ = 8192, MP = 16384, MS = 256, MT = MP + MS, NL = 2;
constexpr int DATT = 512, NH = 8, HD = 64, DSSM = 256, DPOOL = 256, DIN = 2048, DFF = 2816, DUP = 5632;
constexpr int LATT = 2048;
constexpr float EPS = 1e-6f;
constexpr float QSCALE = 0.125f * 1.4426950408889634f;

constexpr size_t O_YP = 0;
constexpr size_t O_YS = O_YP + (size_t)MP * DM;
constexpr size_t O_KP = O_YS + (size_t)MS * DM;
constexpr size_t O_VP = O_KP + (size_t)NL * 2 * LATT * DATT;
constexpr size_t O_SRP = O_VP + (size_t)NL * 2 * LATT * DATT;
constexpr size_t O_SIP = O_SRP + (size_t)NL * 2 * 16 * 64;
constexpr size_t O_PP = O_SIP + (size_t)NL * 2 * 16 * 64;
constexpr size_t O_CP = O_PP + (size_t)NL * 2 * 15 * 256;
constexpr size_t O_KS = O_CP + (size_t)NL * 2 * 2 * DUP;
constexpr size_t O_VS = O_KS + (size_t)NL * MS * DATT;
constexpr size_t O_SRS = O_VS + (size_t)NL * MS * DATT;
constexpr size_t O_SIS = O_SRS + (size_t)NL * 32 * 16 * 64;
constexpr size_t O_PS = O_SIS + (size_t)NL * 32 * 16 * 64;
constexpr size_t O_CS = O_PS + (size_t)NL * 32 * 15 * 256;
constexpr size_t O_END = O_CS + (size_t)NL * 32 * 2 * DUP;
static_assert(O_END == 27118592, "output size");

constexpr size_t MiB = 1u << 20;
constexpr size_t WS_CTL = 0, CTL_ZERO_BYTES = 1 * MiB;
constexpr size_t WS_TAB = 1 * MiB;
constexpr size_t WS_WIN = 2 * MiB;
constexpr size_t WS_WOUT = 10 * MiB;
constexpr size_t WS_WUP = 14 * MiB;
constexpr size_t WS_WDN = 36 * MiB;
constexpr size_t WS_RS1V0 = 48 * MiB, RS_VSTRIDE = 2 * MiB;
constexpr size_t WS_XBV0 = 54 * MiB, XB_VSTRIDE = 33 * MiB;
constexpr size_t WS_XFV0 = 219 * MiB, XF_VSTRIDE = 66 * MiB;
constexpr size_t WS_LAYER0 = 484 * MiB, LSTRIDE = 236 * MiB;
constexpr size_t WS_RS2 = 0 * MiB;
constexpr size_t WS_HEND = 2 * MiB;
constexpr size_t WS_QB = 4 * MiB;
constexpr size_t WS_KB = 21 * MiB;
constexpr size_t WS_VB = 38 * MiB;
constexpr size_t WS_US = 55 * MiB;
constexpr size_t WS_UPL = 72 * MiB;
constexpr size_t WS_MIX = 89 * MiB;
constexpr size_t WS_ACT = 122 * MiB;
constexpr size_t WS_HALO = 212 * MiB;
constexpr size_t WS_END = WS_LAYER0 + NL * LSTRIDE;
static_assert(WS_HALO + (size_t)260 * 4 * DUP * 4 <= LSTRIDE && WS_ACT + (size_t)MT * DFF * 2 <= WS_HALO && WS_MIX + (size_t)MT * DM * 2 <= WS_ACT && WS_UPL + (size_t)MT * 1024 <= WS_MIX, "layer block");
static_assert(WS_XBV0 + 5 * XB_VSTRIDE <= WS_XFV0 && WS_XFV0 + 4 * XF_VSTRIDE <= WS_LAYER0 && (size_t)MT * DM * 4 <= XF_VSTRIDE && (size_t)MT * DM * 2 <= XB_VSTRIDE, "residual versions");
static_assert(WS_WUP + (size_t)NL * DUP * DM * 2 <= WS_WDN && WS_WDN + (size_t)NL * DM * DFF * 2 <= WS_RS1V0 && WS_RS1V0 + 3 * RS_VSTRIDE <= WS_XBV0, "ws map");
constexpr int TAB_AB = 0;
constexpr int TAB_ABL = 2048;
constexpr int TAB_BB = 4096;
constexpr int TAB_PER_L = 4096 + 32768;
constexpr size_t WS_WG = WS_TAB + 512 * 1024;
constexpr size_t WS_PW = WS_TAB + 768 * 1024;

constexpr int LDS_BYTES = 147456;

#define GAS __attribute__((address_space(1)))
#define LAS __attribute__((address_space(3)))
typedef unsigned short bf16;
typedef unsigned v4u __attribute__((ext_vector_type(4)));
typedef unsigned v2u __attribute__((ext_vector_type(2)));
typedef float f32x4 __attribute__((ext_vector_type(4)));
using pg8::Unit;

__device__ __forceinline__ unsigned f2bf(float f) { unsigned u = __builtin_bit_cast(unsigned, f); return (u + 0x7fffu + ((u >> 16) & 1u)) >> 16; }
__device__ __forceinline__ unsigned pk2(float lo, float hi) { return f2bf(lo) | (f2bf(hi) << 16); }
__device__ __forceinline__ float bflo(unsigned w) { return __uint_as_float(w << 16); }
__device__ __forceinline__ float bfhi(unsigned w) { return __uint_as_float(w & 0xffff0000u); }
__device__ __forceinline__ float wave_sum(float v) {
#pragma unroll
    for (int o = 1; o < 64; o <<= 1) v += __shfl_xor(v, o);
    return v;
}
__device__ __forceinline__ float sigmoidf_(float x) { return __builtin_amdgcn_rcpf(1.0f + __builtin_amdgcn_exp2f(-1.4426950408889634f * x)); }
__device__ __forceinline__ float gelu_tanh(float x) {
    const float z = 0.7978845608028654f * (x + 0.044715f * x * x * x);
    const float t = 1.0f - 2.0f * __builtin_amdgcn_rcpf(1.0f + __builtin_amdgcn_exp2f(2.8853900817779268f * z));
    return 0.5f * x * (1.0f + t);
}


struct Args { const float* in[32]; float* out; unsigned char* ws; int ph_lo, ph_hi, probe_sub, probe_n; };

typedef const float* cfp;
typedef const __attribute__((address_space(4))) cfp* kin_t;
__device__ __forceinline__ kin_t kin() { kin_t p = (kin_t)__builtin_amdgcn_kernarg_segment_ptr(); asm volatile("" : "+s"(p)); return p; }

struct Frame {
    LAS unsigned char* lds;
    int tid, lane, wave, G, bx;
    unsigned char* wl;
    float* out; unsigned char* ws;
};
__device__ __forceinline__ unsigned char* layer_base(unsigned char* ws, int L) { return ws + WS_LAYER0 + (size_t)L * LSTRIDE; }

__device__ __forceinline__ void transpose_item(const float* W, int K, int N, bf16* WT, int gmode, const float* g0, const float* g1, const float* g2,
                                               bool perm_up, LAS float* scr, int item, int lane) {
    const int nblk = N / 32, kb = item / nblk, nb = item % nblk, k0 = 64 * kb, n0 = 32 * nb;
#pragma unroll 8
    for (int i = 0; i < 32; ++i) {
        const int kk = 2 * i + (lane >> 5), k = k0 + kk;
        float g = 1.0f;
        if (gmode == 1) g = g0[k];
        else if (gmode == 2) g = (k < 512) ? g0[k] : (k < 768 ? g1[k - 512] : g2[k - 768]);
        scr[kk * 33 + (lane & 31)] = W[(size_t)k * N + n0 + (lane & 31)] * g;
    }
    asm volatile("s_waitcnt lgkmcnt(0)" ::: "memory");
    int nr0 = n0;
    if (perm_up) { nr0 = (n0 < DFF) ? (256 * (n0 / 128) + (n0 % 128)) : (256 * ((n0 - DFF) / 128) + 128 + ((n0 - DFF) % 128)); }
    const int c = lane & 7;
#pragma unroll
    for (int j = 0; j < 4; ++j) {
        const int n = (lane >> 3) + 8 * j; const LAS float* s = scr + (8 * c) * 33 + n;
        v4u o; o.x = pk2(s[0 * 33], s[1 * 33]); o.y = pk2(s[2 * 33], s[3 * 33]); o.z = pk2(s[4 * 33], s[5 * 33]); o.w = pk2(s[6 * 33], s[7 * 33]);
        *(GAS v4u*)(WT + (size_t)(nr0 + n) * K + k0 + 8 * c) = o;
    }
    asm volatile("s_waitcnt lgkmcnt(0)" ::: "memory");
}

__device__ __forceinline__ void ph_prologue(Frame& F) {
    const kin_t IN = kin();
    LAS float* scr = (LAS float*)(F.lds + F.wave * 16384);
    const int gw = F.bx * 8 + F.wave, NGW = F.G * 8;
    constexpr int I_IN = 16 * 64, I_OUT = 16 * 32, I_UP = 16 * 176, I_DN = 44 * 32, I_WG = 4 * 8, I_PW = 4 * 2, PER_L = I_IN + I_OUT + I_UP + I_DN + I_WG + I_PW;
    for (int it = gw; it < NL * PER_L; it += NGW) {
        const int L = it / PER_L; int r = it % PER_L;
        if (r < I_IN) { transpose_item(IN[9] + (size_t)L * DM * DIN, DM, DIN, (bf16*)(F.ws + WS_WIN) + (size_t)L * DIN * DM, 1, IN[8] + L * DM, nullptr, nullptr, false, scr, r, F.lane); continue; }
        r -= I_IN;
        if (r < I_OUT) { transpose_item(IN[25] + (size_t)L * DM * DM, DM, DM, (bf16*)(F.ws + WS_WOUT) + (size_t)L * DM * DM, 2, IN[22] + L * 512, IN[23] + L * 256, IN[24] + L * 256, false, scr, r, F.lane); continue; }
        r -= I_OUT;
        if (r < I_UP) { transpose_item(IN[27] + (size_t)L * DM * DUP, DM, DUP, (bf16*)(F.ws + WS_WUP) + (size_t)L * DUP * DM, 1, IN[26] + L * DM, nullptr, nullptr, true, scr, r, F.lane); continue; }
        r -= I_UP;
        if (r < I_DN) { transpose_item(IN[30] + (size_t)L * DFF * DM, DFF, DM, (bf16*)(F.ws + WS_WDN) + (size_t)L * DM * DFF, 0, nullptr, nullptr, nullptr, false, scr, r, F.lane); continue; }
        r -= I_DN;
        if (r < I_WG) { transpose_item(IN[18] + (size_t)L * 65536, 256, 256, (bf16*)(F.ws + WS_WG) + (size_t)L * 65536, 0, nullptr, nullptr, nullptr, false, scr, r, F.lane); continue; }
        r -= I_WG;
        { const int gi = r >> 1; transpose_item(IN[20] + (size_t)(L * 4 + gi) * 4096, 64, 64, (bf16*)(F.ws + WS_PW) + (size_t)(L * 4 + gi) * 4096, 0, nullptr, nullptr, nullptr, false, scr, r & 1, F.lane); }
    }
    bf16* Xb = (bf16*)(F.ws + WS_XBV0); float* rs1 = (float*)(F.ws + WS_RS1V0);
    for (int blk = F.bx; blk < MT / 32; blk += F.G) {
#pragma unroll 1
        for (int r4 = 0; r4 < 4; ++r4) {
            const int m = blk * 32 + F.wave * 4 + r4;
            const float* xrow = (m < MP) ? IN[0] + (size_t)m * DM : IN[1] + (size_t)(m - MP) * DM;
            const GAS f32x4* xr = (const GAS f32x4*)xrow + F.lane;
            GAS v2u* o8 = (GAS v2u*)(Xb + (size_t)m * DM) + F.lane;
#pragma unroll
            for (int j = 0; j < 4; ++j) {
                const f32x4 v = xr[64 * j];
                float s = (v.x * v.x + v.y * v.y) + (v.z * v.z + v.w * v.w);
                s += __shfl_xor(s, 1); s += __shfl_xor(s, 2); s += __shfl_xor(s, 4); s += __shfl_xor(s, 8);
                if ((F.lane & 15) == 0) rs1[(size_t)(4 * j + (F.lane >> 4)) * MT + m] = s;
                v2u w; w.x = pk2(v.x, v.y); w.y = pk2(v.z, v.w); o8[64 * j] = w;
            }
        }
    }
    const int gt = F.bx * 512 + F.tid;
    if (gt < NL * 1024) {
        const int L = gt >> 10, g = (gt >> 6) & 15, p = gt & 63;
        float* tab = (float*)(F.ws + WS_TAB) + (size_t)L * TAB_PER_L;
        const float dt = expf(IN[10][L * 16 + g]);
        const float are = IN[11][(L * 16 + g) * 64 + p], aim = IN[12][(L * 16 + g) * 64 + p];
        const float mag = expf(dt * are), ang = dt * aim;
        const float abr = mag * cosf(ang), abi = mag * sinf(ang);
        const float den = are * are + aim * aim, nre = abr - 1.0f, nim = abi;
        const float cor = (nre * are + nim * aim) / den, coi = (nim * are - nre * aim) / den;
        tab[TAB_AB + (g * 2 + 0) * 64 + p] = abr; tab[TAB_AB + (g * 2 + 1) * 64 + p] = abi;
        float pr = abr, pi = abi;
#pragma unroll
        for (int i = 0; i < 6; ++i) { const float nr = pr * pr - pi * pi, ni = 2.0f * pr * pi; pr = nr; pi = ni; }
        tab[TAB_ABL + (g * 2 + 0) * 64 + p] = pr; tab[TAB_ABL + (g * 2 + 1) * 64 + p] = pi;
        for (int c = 0; c < 16; ++c) {
            const float br = IN[13][((size_t)(L * 16 + g) * 64 + p) * 16 + c], bi = IN[14][((size_t)(L * 16 + g) * 64 + p) * 16 + c];
            tab[TAB_BB + (g * 32 + 2 * c) * 64 + p] = cor * br - coi * bi;
            tab[TAB_BB + (g * 32 + 2 * c + 1) * 64 + p] = cor * bi + coi * br;
        }
    }
    for (int i = gt; i < NL * 32 * 7 * 256; i += F.G * 512) {
        const int ch = i & 255, r = (i >> 8) % 7, lb = (i >> 8) / 7;
        F.out[O_PS + ((size_t)lb * 15 + r) * 256 + ch] = IN[6][((size_t)lb * 15 + 8 + r) * 256 + ch];
    }
}

__device__ __forceinline__ float rstd_from_partials(const float* rs, int row, float inv_n) {
    float ss = 0.f;
#pragma unroll
    for (int s = 0; s < 16; ++s) ss += rs[(size_t)s * MT + row];
    return rsqrtf(ss * inv_n + EPS);
}
__device__ __forceinline__ float rstd_from_partials_q(const float* rs, int row, int fq, float inv_n) {
    const float* p = rs + (size_t)(4 * fq) * MT + row;
    float ss = (p[0] + p[MT]) + (p[2 * (size_t)MT] + p[3 * (size_t)MT]);
    ss += __shfl_xor(ss, 16); ss += __shfl_xor(ss, 32);
    return rsqrtf(ss * inv_n + EPS);
}
__device__ __forceinline__ void st_bf4(bf16* p, f32x4 v) { v2u w; w.x = pk2(v.x, v.y); w.y = pk2(v.z, v.w); *(GAS v2u*)p = w; }

struct Epi1Ptrs { const float* rs; bf16 *Q, *K, *V; float *Us, *Upl, *okp, *ovp, *oks, *ovs, *opp, *ops; };
__device__ __forceinline__ Epi1Ptrs epi1_ptrs(unsigned char* ws_, float* out_, int L_) {
    Epi1Ptrs p; unsigned char* wl_ = layer_base(ws_, L_);
    p.rs = (const float*)(ws_ + WS_RS1V0 + (size_t)L_ * RS_VSTRIDE);
    p.Q = (bf16*)(wl_ + WS_QB); p.K = (bf16*)(wl_ + WS_KB); p.V = (bf16*)(wl_ + WS_VB); p.Us = (float*)(wl_ + WS_US); p.Upl = (float*)(wl_ + WS_UPL);
    p.okp = out_ + O_KP + (size_t)L_ * 2 * LATT * DATT; p.ovp = out_ + O_VP + (size_t)L_ * 2 * LATT * DATT;
    p.oks = out_ + O_KS + (size_t)L_ * MS * DATT; p.ovs = out_ + O_VS + (size_t)L_ * MS * DATT;
    p.opp = out_ + O_PP + (size_t)L_ * 2 * 15 * 256; p.ops = out_ + O_PS + (size_t)L_ * 32 * 15 * 256;
    return p;
}
__device__ __forceinline__ void epi1_store(const Epi1Ptrs& P, int row, int pn, int lc, const f32x4 v) {
    const bool samp = row >= MP; const int t = row & (SEQ - 1), b = row >> 13, srow = row - MP;
    if (pn < 2) { st_bf4(P.Q + (size_t)row * 512 + pn * 256 + lc, v * QSCALE); }
    else if (pn < 6) {
        const bool isk = pn < 4; const int col = (pn & 1) * 256 + lc;
        st_bf4((isk ? P.K : P.V) + (size_t)row * 512 + col, v);
        if (samp) *(GAS f32x4*)((isk ? P.oks : P.ovs) + (size_t)srow * 512 + col) = v;
        else if (t >= SEQ - LATT) *(GAS f32x4*)((isk ? P.okp : P.ovp) + ((size_t)b * LATT + (t - (SEQ - LATT))) * 512 + col) = v;
    } else if (pn == 6) { *(GAS f32x4*)(P.Us + (size_t)row * 256 + lc) = v; }
    else {
        *(GAS f32x4*)(P.Upl + (size_t)row * 256 + lc) = v;
        if (samp) *(GAS f32x4*)(P.ops + ((size_t)(srow >> 3) * 15 + 7 + (srow & 7)) * 256 + lc) = v;
        else if (t >= SEQ - 15) *(GAS f32x4*)(P.opp + ((size_t)b * 15 + (t - (SEQ - 15))) * 256 + lc) = v;
    }
}
struct Epi1 {
    static constexpr bool PERM = false, AFTER_DRAIN = false;
    unsigned char* ws; float* out; int L;
    __device__ __forceinline__ void operator()(const f32x4 (&acc)[2][2][4][2], const Unit& u, int wr, int wc, int fr, int fq) const {
        unsigned char* ws_ = ws; float* out_ = out; int L_ = L; asm volatile("" : "+s"(ws_), "+s"(out_), "+s"(L_));
        const Epi1Ptrs P = epi1_ptrs(ws_, out_, L_);
        const int pn = u.pn;
#pragma unroll
        for (int ai = 0; ai < 2; ++ai)
#pragma unroll
            for (int m = 0; m < 4; ++m) {
                const int row = u.pm * 256 + ai * 128 + wr * 64 + m * 16 + fr;
                const float rstd = rstd_from_partials_q(P.rs, row, fq, 1.0f / 1024.0f);
#pragma unroll
                for (int bj = 0; bj < 2; ++bj)
#pragma unroll
                    for (int n = 0; n < 2; ++n) epi1_store(P, row, pn, bj * 128 + wc * 32 + n * 16 + fq * 4, acc[ai][bj][m][n] * rstd);
                asm volatile("" ::: "memory");
            }
    }
};

struct EpiRes {
    static constexpr bool PERM = false, AFTER_DRAIN = false;
    unsigned char* ws; const float *xp, *xs;
    int xin_off, xf_off, xb_off, rs_off;
    __device__ __forceinline__ void operator()(const f32x4 (&acc)[2][2][4][2], const Unit& u, int wr, int wc, int fr, int fq) const {
        unsigned char* ws_ = ws; int ro_ = rs_off, xi_ = xin_off, xf_ = xf_off, xb_ = xb_off; asm volatile("" : "+s"(ws_), "+s"(ro_), "+s"(xi_), "+s"(xf_), "+s"(xb_));
        const float* Xin = (const float*)(ws_ + xi_); float* Xf = (float*)(ws_ + xf_); bf16* Xb = (bf16*)(ws_ + xb_); float* rso = (float*)(ws_ + ro_);
        const int pn = u.pn;
#pragma unroll
        for (int ai = 0; ai < 2; ++ai)
#pragma unroll
            for (int m = 0; m < 4; ++m) {
                const int row = u.pm * 256 + ai * 128 + wr * 64 + m * 16 + fr;
                const float* brow = xp ? (row < MP ? xp + (size_t)row * DM : xs + (size_t)(row - MP) * DM) : Xin + (size_t)row * DM;
                float ss = 0.f;
#pragma unroll
                for (int bj = 0; bj < 2; ++bj)
#pragma unroll
                    for (int n = 0; n < 2; ++n) {
                        const int col = pn * 256 + bj * 128 + wc * 32 + n * 16 + fq * 4;
                        const f32x4 v = acc[ai][bj][m][n] + *(const GAS f32x4*)(brow + col);
                        *(GAS f32x4*)(Xf + (size_t)row * DM + col) = v;
                        st_bf4(Xb + (size_t)row * DM + col, v);
                        ss += (v.x * v.x + v.y * v.y) + (v.z * v.z + v.w * v.w);
                    }
                ss += __shfl_xor(ss, 16); ss += __shfl_xor(ss, 32);
                if (fq == 0) rso[(size_t)(pn * 4 + wc) * MT + row] = ss;
                asm volatile("" ::: "memory");
            }
    }
};

template <int N> __device__ __forceinline__ float row_ror(float v) { return __builtin_bit_cast(float, __builtin_amdgcn_update_dpp(0, __builtin_bit_cast(int, v), 0x120 + N, 0xf, 0xf, false)); }
template <int N> __device__ __forceinline__ f32x4 row_ror4(const f32x4 v) { return (f32x4){row_ror<N>(v.x), row_ror<N>(v.y), row_ror<N>(v.z), row_ror<N>(v.w)}; }
__device__ __forceinline__ f32x4 sel4(bool c, const f32x4 a, const f32x4 b) { return (f32x4){c ? a.x : b.x, c ? a.y : b.y, c ? a.z : b.z, c ? a.w : b.w}; }
__device__ __forceinline__ f32x4 silu_gate4(const f32x4 g, const f32x4 a) { return (f32x4){g.x * sigmoidf_(g.x) * a.x, g.y * sigmoidf_(g.y) * a.y, g.z * sigmoidf_(g.z) * a.z, g.w * sigmoidf_(g.w) * a.w}; }

struct Epi3 {
    static constexpr bool PERM = false, AFTER_DRAIN = false;
    unsigned char* ws; float* out; int L; const float *cwp, *cbp, *scp;
    __device__ __forceinline__ void operator()(f32x4 (&acc)[2][2][4][2], const Unit& u, int wr, int wc, int fr, int fq) const {
        unsigned char* ws_ = ws; float* out_ = out; int L_ = L; asm volatile("" : "+s"(ws_), "+s"(out_), "+s"(L_));
        unsigned char* wl_ = layer_base(ws_, L_);
        const float* rs = (const float*)(wl_ + WS_RS2); bf16* Act = (bf16*)(wl_ + WS_ACT); float* halo = (float*)(wl_ + WS_HALO);
        float* ocp = out_ + O_CP + (size_t)L_ * 2 * 2 * DUP; float* ocs = out_ + O_CS + (size_t)L_ * 32 * 2 * DUP;
        const int pn = u.pn; const bool stile = u.pm == MP / 256;
#pragma unroll
        for (int ai = 0; ai < 2; ++ai)
#pragma unroll
            for (int m = 0; m < 4; ++m) {
                const int row = u.pm * 256 + ai * 128 + wr * 64 + m * 16 + fr;
                const float rstd = rstd_from_partials_q(rs, row, fq, 1.0f / 1024.0f);
                const int t = row & (SEQ - 1), b = row >> 13, srow = row - MP;
#pragma unroll
                for (int bj = 0; bj < 2; ++bj)
#pragma unroll
                    for (int n = 0; n < 2; ++n) {
                        const f32x4 v = acc[ai][bj][m][n] * rstd; acc[ai][bj][m][n] = v;
                        const int lc = bj * 128 + wc * 32 + n * 16 + fq * 4, oc = bj * DFF + 128 * pn + (lc - bj * 128);
                        if (stile) { if ((srow & 7) >= 6) *(GAS f32x4*)(ocs + ((size_t)(srow >> 3) * 2 + ((srow & 7) - 6)) * DUP + oc) = v; }
                        else {
                            if (t >= SEQ - 2) *(GAS f32x4*)(ocp + ((size_t)b * 2 + (t - (SEQ - 2))) * DUP + oc) = v;
                            if (m == 0 && fr < 2) *(GAS f32x4*)(halo + ((size_t)(row >> 6) * 4 + fr) * DUP + pn * 256 + lc) = v;
                            if (m == 3 && fr >= 14) *(GAS f32x4*)(halo + ((size_t)(row >> 6) * 4 + (fr - 12)) * DUP + pn * 256 + lc) = v;
                        }
                    }
            }
        f32x4 cwv[2][8];
#pragma unroll
        for (int n = 0; n < 2; ++n) {
            const int ca = 128 * pn + wc * 32 + n * 16 + fq * 4, cg = DFF + ca;
            cwv[n][0] = *(const GAS f32x4*)(cwp + ca); cwv[n][1] = *(const GAS f32x4*)(cwp + DUP + ca); cwv[n][2] = *(const GAS f32x4*)(cwp + 2 * DUP + ca); cwv[n][3] = *(const GAS f32x4*)(cbp + ca);
            cwv[n][4] = *(const GAS f32x4*)(cwp + cg); cwv[n][5] = *(const GAS f32x4*)(cwp + DUP + cg); cwv[n][6] = *(const GAS f32x4*)(cwp + 2 * DUP + cg); cwv[n][7] = *(const GAS f32x4*)(cbp + cg);
        }
#pragma unroll
        for (int n = 0; n < 2; ++n) {
            const int ca = 128 * pn + wc * 32 + n * 16 + fq * 4, cg = DFF + ca;
            const f32x4 wa0 = cwv[n][0], wa1 = cwv[n][1], wa2 = cwv[n][2], ba = cwv[n][3], wg0 = cwv[n][4], wg1 = cwv[n][5], wg2 = cwv[n][6], bg = cwv[n][7];
#pragma unroll
            for (int ai = 0; ai < 2; ++ai)
#pragma unroll
                for (int m = 0; m < 4; ++m) {
                    const int row = u.pm * 256 + ai * 128 + wr * 64 + m * 16 + fr;
                    const f32x4 xa = acc[ai][0][m][n], xg = acc[ai][1][m][n];
                    const f32x4 pa = acc[ai][0][m > 0 ? m - 1 : 0][n], pg = acc[ai][1][m > 0 ? m - 1 : 0][n];
                    f32x4 a1 = sel4(fr == 0, row_ror4<1>(pa), row_ror4<1>(xa)), a2 = sel4(fr < 2, row_ror4<2>(pa), row_ror4<2>(xa));
                    f32x4 g1 = sel4(fr == 0, row_ror4<1>(pg), row_ror4<1>(xg)), g2 = sel4(fr < 2, row_ror4<2>(pg), row_ror4<2>(xg));
                    bool store = m > 0 || fr >= 2;
                    if (stile) {
                        const int srow = row - MP, t = srow & 7; const float* pr = scp + (size_t)(srow >> 3) * 2 * DUP;
                        if (t == 0) { a1 = *(const GAS f32x4*)(pr + DUP + ca); g1 = *(const GAS f32x4*)(pr + DUP + cg); a2 = *(const GAS f32x4*)(pr + ca); g2 = *(const GAS f32x4*)(pr + cg); }
                        else if (t == 1) { a2 = *(const GAS f32x4*)(pr + DUP + ca); g2 = *(const GAS f32x4*)(pr + DUP + cg); }
                        store = true;
                    }
                    const f32x4 av = ba + a2 * wa0 + a1 * wa1 + xa * wa2, gv = bg + g2 * wg0 + g1 * wg1 + xg * wg2;
                    if (store) st_bf4(Act + (size_t)row * DFF + ca, silu_gate4(gv, av));
                }
        }
    }
};
#define XB_TMO      128
#define XB_XCNT(j)  (256  + 64 * (j))
#define XB_XSUB(j)  (1280 + 64 * (j))
#define XB_XGEN(j)  (2304 + 64 * (j))
#define XB_TOP      3328
#define XB_TOPGEN   3392
#define XCD_BAR_WORDS 3456
#define XB_SPIN_CAP (1u << 22)

__device__ __forceinline__ unsigned xb_ld(unsigned* p)              { return __hip_atomic_load(p, __ATOMIC_RELAXED, __HIP_MEMORY_SCOPE_AGENT); }
__device__ __forceinline__ unsigned xb_add(unsigned* p, unsigned v) { return __hip_atomic_fetch_add(p, v, __ATOMIC_RELAXED, __HIP_MEMORY_SCOPE_AGENT); }
__device__ __forceinline__ unsigned xb_xcc_id() { return (unsigned)__builtin_amdgcn_s_getreg((3 << 11) | 20) & 0xFu; }
#define XB_SPIN(cond, bar) do { unsigned _sp = 0; while (cond) { __builtin_amdgcn_s_sleep(1); \
    if ((++_sp & 255u) == 0u) { if (xb_ld(&(bar)[XB_TMO])) break; if (_sp > XB_SPIN_CAP) { atomicAdd(&(bar)[XB_TMO], 1u); break; } } } } while (0)

struct XcdBarrier {
    unsigned* bar; unsigned x;
    volatile LAS unsigned* st;
};

__device__ __forceinline__ XcdBarrier xcd_barrier_post(unsigned* bar, volatile LAS unsigned* st) {
    XcdBarrier b; b.bar = bar; b.x = xb_xcc_id(); b.st = st;
    if (threadIdx.x == 0) (void)xb_add(&bar[XB_XCNT(b.x)], 1u);
    return b;
}
__device__ __forceinline__ void xcd_barrier_complete(unsigned* bar, unsigned x, unsigned& nloc, unsigned& nx) {
    const unsigned G = gridDim.x * gridDim.y * gridDim.z;
    unsigned sum, cnt, mine, sp = 0u;
    for (;;) {
        sum = 0u; cnt = 0u; mine = 0u;
#pragma unroll
        for (unsigned j = 0; j < 16; ++j) { const unsigned c = xb_ld(&bar[XB_XCNT(j)]); sum += c; cnt += (c > 0u) ? 1u : 0u; mine = (j == x) ? c : mine; }
        if (sum == G) break;
        __builtin_amdgcn_s_sleep(1);
        if ((++sp & 255u) == 0u) { if (xb_ld(&bar[XB_TMO])) break; if (sp > XB_SPIN_CAP) { atomicAdd(&bar[XB_TMO], 1u); break; } }
    }
    nloc = mine > 0u ? mine : 1u; nx = cnt > 0u ? cnt : 1u;
}

__device__ __forceinline__ void xcd_barrier(const XcdBarrier& b) {
    asm volatile("s_waitcnt vmcnt(0)" ::: "memory");
    __syncthreads();
    if (threadIdx.x == 0) {
        unsigned* bar = b.bar;
        __builtin_amdgcn_s_waitcnt(0);
        unsigned nloc = b.st[0], nx = b.st[1];
        if (nloc == 0u) { xcd_barrier_complete(bar, b.x, nloc, nx); b.st[0] = nloc; b.st[1] = nx; }
        const unsigned old = xb_add(&bar[XB_XSUB(b.x)], 1u);
        const unsigned gen = old / nloc;
        if (old + 1u == (gen + 1u) * nloc) {
            __builtin_amdgcn_fence(__ATOMIC_RELEASE, "agent");
            asm volatile("s_waitcnt vmcnt(0)" ::: "memory");
            const unsigned og = xb_add(&bar[XB_TOP], 1u);
            const unsigned tg = og / nx;
            if (og + 1u == (tg + 1u) * nx) xb_add(&bar[XB_TOPGEN], 1u);
            else XB_SPIN(xb_ld(&bar[XB_TOPGEN]) == tg, bar);
            __builtin_amdgcn_fence(__ATOMIC_ACQUIRE, "agent");
            xb_add(&bar[XB_XGEN(b.x)], 1u);
            asm volatile("s_waitcnt vmcnt(0)" ::: "memory");
        } else {
            XB_SPIN(xb_ld(&bar[XB_XGEN(b.x)]) == gen, bar);
            __builtin_amdgcn_fence(__ATOMIC_ACQUIRE, "agent");
            asm volatile("s_waitcnt vmcnt(0)" ::: "memory");
        }
    }
    __syncthreads();
}

__device__ __forceinline__ float rdlane(float v, int l) { return __builtin_bit_cast(float, __builtin_amdgcn_readlane(__builtin_bit_cast(int, v), l)); }

__device__ __forceinline__ void ph_ssm1(Frame& F, int L) {
    const float* tab = (const float*)(F.ws + WS_TAB) + (size_t)L * TAB_PER_L;
    const float* Us = (const float*)(F.wl + WS_US);
    float* Hend = (float*)(F.wl + WS_HEND);
    for (int unit = F.bx; unit < 256; unit += F.G) {
        const int base = unit * 64;
        const int g0 = F.wave * 2, g1 = g0 + 1;
        const float ar0 = tab[TAB_AB + (g0 * 2 + 0) * 64 + F.lane], ai0 = tab[TAB_AB + (g0 * 2 + 1) * 64 + F.lane];
        const float ar1 = tab[TAB_AB + (g1 * 2 + 0) * 64 + F.lane], ai1 = tab[TAB_AB + (g1 * 2 + 1) * 64 + F.lane];
        float bb0[32], bb1[32];
#pragma unroll
        for (int c = 0; c < 32; ++c) { bb0[c] = tab[TAB_BB + (g0 * 32 + c) * 64 + F.lane]; bb1[c] = tab[TAB_BB + (g1 * 32 + c) * 64 + F.lane]; }
        float h0r = 0.f, h0i = 0.f, h1r = 0.f, h1i = 0.f;
        for (int s0 = 0; s0 < 64; s0 += 8) {
            float uv[8];
#pragma unroll
            for (int k = 0; k < 8; ++k) uv[k] = Us[(size_t)(base + s0 + k) * 256 + g0 * 16 + (F.lane & 31)];
#pragma unroll
            for (int k = 0; k < 8; ++k) {
                float b0r = 0.f, b0i = 0.f, b1r = 0.f, b1i = 0.f;
#pragma unroll
                for (int c = 0; c < 16; ++c) { const float u0 = rdlane(uv[k], c), u1 = rdlane(uv[k], 16 + c);
                    b0r += bb0[2 * c] * u0; b0i += bb0[2 * c + 1] * u0; b1r += bb1[2 * c] * u1; b1i += bb1[2 * c + 1] * u1; }
                const float n0r = ar0 * h0r - ai0 * h0i + b0r, n0i = ar0 * h0i + ai0 * h0r + b0i; h0r = n0r; h0i = n0i;
                const float n1r = ar1 * h1r - ai1 * h1i + b1r, n1i = ar1 * h1i + ai1 * h1r + b1i; h1r = n1r; h1i = n1i;
            }
        }
        Hend[((size_t)unit * 16 + g0) * 128 + F.lane] = h0r; Hend[((size_t)unit * 16 + g0) * 128 + 64 + F.lane] = h0i;
        Hend[((size_t)unit * 16 + g1) * 128 + F.lane] = h1r; Hend[((size_t)unit * 16 + g1) * 128 + 64 + F.lane] = h1i;
    }
}

__device__ __forceinline__ void ld16_bf(const bf16* p, float (&f)[16]) {
    const v4u a = *(const GAS v4u*)p, b = *(const GAS v4u*)(p + 8);
    f[0] = bflo(a.x); f[1] = bfhi(a.x); f[2] = bflo(a.y); f[3] = bfhi(a.y); f[4] = bflo(a.z); f[5] = bfhi(a.z); f[6] = bflo(a.w); f[7] = bfhi(a.w);
    f[8] = bflo(b.x); f[9] = bfhi(b.x); f[10] = bflo(b.y); f[11] = bfhi(b.y); f[12] = bflo(b.z); f[13] = bfhi(b.z); f[14] = bflo(b.w); f[15] = bfhi(b.w);
}
__device__ __forceinline__ void ld16_f32(const float* p, float (&f)[16]) {
    const GAS f32x4* q = (const GAS f32x4*)p;
#pragma unroll
    for (int i = 0; i < 4; ++i) { const f32x4 v = q[i]; f[4 * i] = v.x; f[4 * i + 1] = v.y; f[4 * i + 2] = v.z; f[4 * i + 3] = v.w; }
}

template <bool SAMPLE>
__device__ __forceinline__ void attn_row(const Frame& F, int L, int row, int bb, int t, int h, float (&o)[16]) {
    const kin_t IN = kin();
    const int ks = F.lane >> 2, dq = F.lane & 3;
    const bf16* Qb = (const bf16*)(F.wl + WS_QB); const bf16* Kb = (const bf16*)(F.wl + WS_KB); const bf16* Vb = (const bf16*)(F.wl + WS_VB);
    const float* ck = IN[2] + ((size_t)(L * 32 + bb) * LATT) * 512; const float* cv = IN[3] + ((size_t)(L * 32 + bb) * LATT) * 512;
    const int hoff = h * 64 + dq * 16;
    float q[16]; ld16_bf(Qb + (size_t)row * 512 + hoff, q);
    float m = -1e30f, l = 0.f, acc[16];
#pragma unroll
    for (int i = 0; i < 16; ++i) acc[i] = 0.f;
#pragma unroll 3
    for (int it = 0; it < 27; ++it) {
        const int gi = it / 9, s = it - gi * 9, d = 1 << (2 * gi);
        const int j = s * 16 + ks; bool valid = j <= 128; float k[16], v[16];
        if (!SAMPLE) { int pos = t - d * j; valid = valid && pos >= 0; if (!valid) pos = t;
                       ld16_bf(Kb + (size_t)(bb * SEQ + pos) * 512 + hoff, k); ld16_bf(Vb + (size_t)(bb * SEQ + pos) * 512 + hoff, v); }
        else { int idx = LATT + t - d * j; if (!valid) idx = LATT + t;
               if (idx >= LATT) { ld16_bf(Kb + (size_t)(MP + bb * 8 + (idx - LATT)) * 512 + hoff, k); ld16_bf(Vb + (size_t)(MP + bb * 8 + (idx - LATT)) * 512 + hoff, v); }
               else { ld16_f32(ck + (size_t)idx * 512 + hoff, k); ld16_f32(cv + (size_t)idx * 512 + hoff, v); } }
        float dot = 0.f;
#pragma unroll
        for (int i = 0; i < 16; ++i) dot += q[i] * k[i];
        dot += __shfl_xor(dot, 1); dot += __shfl_xor(dot, 2);
        dot = valid ? dot : -1e30f;
        const float mn = fmaxf(m, dot), sc = __builtin_amdgcn_exp2f(m - mn), p = __builtin_amdgcn_exp2f(dot - mn);
        m = mn; l = l * sc + p;
#pragma unroll
        for (int i = 0; i < 16; ++i) acc[i] = acc[i] * sc + p * v[i];
    }
    float M = m;
    M = fmaxf(M, __shfl_xor(M, 4)); M = fmaxf(M, __shfl_xor(M, 8)); M = fmaxf(M, __shfl_xor(M, 16)); M = fmaxf(M, __shfl_xor(M, 32));
    const float f = __builtin_amdgcn_exp2f(m - M);
    l *= f; l += __shfl_xor(l, 4); l += __shfl_xor(l, 8); l += __shfl_xor(l, 16); l += __shfl_xor(l, 32);
    const float rl = 1.0f / l;
#pragma unroll
    for (int i = 0; i < 16; ++i) { float a = acc[i] * f; a += __shfl_xor(a, 4); a += __shfl_xor(a, 8); a += __shfl_xor(a, 16); a += __shfl_xor(a, 32); o[i] = a * rl; }
}

__device__ __forceinline__ void attn_store(Frame& F, int row, int h, const float (&o)[16], int parity) {
    const int ks = F.lane >> 2, dq = F.lane & 3;
    float ss = 0.f;
#pragma unroll
    for (int i = 0; i < 16; ++i) ss += o[i] * o[i];
    ss += __shfl_xor(ss, 1); ss += __shfl_xor(ss, 2);
    LAS float* red = (LAS float*)F.lds + parity * 8;
    if (F.lane == 0) red[h] = ss;
    __syncthreads();
    float tot = 0.f;
#pragma unroll
    for (int w = 0; w < 8; ++w) tot += red[w];
    const float rstd = rsqrtf(tot * (1.0f / 512.0f) + EPS);
    if (ks == 0) {
        bf16* mp = (bf16*)(F.wl + WS_MIX) + (size_t)row * DM + h * 64 + dq * 16;
        v4u a, b;
        a.x = pk2(o[0] * rstd, o[1] * rstd); a.y = pk2(o[2] * rstd, o[3] * rstd); a.z = pk2(o[4] * rstd, o[5] * rstd); a.w = pk2(o[6] * rstd, o[7] * rstd);
        b.x = pk2(o[8] * rstd, o[9] * rstd); b.y = pk2(o[10] * rstd, o[11] * rstd); b.z = pk2(o[12] * rstd, o[13] * rstd); b.w = pk2(o[14] * rstd, o[15] * rstd);
        *(GAS v4u*)mp = a; *(GAS v4u*)(mp + 8) = b;
    }
}

typedef short bf16x8_t __attribute__((ext_vector_type(8)));
typedef short s16x4_t __attribute__((ext_vector_type(4)));
#define MFMA16(a, b, c) __builtin_amdgcn_mfma_f32_16x16x32_bf16((a), (b), (c), 0, 0, 0)
__device__ __forceinline__ bf16x8_t pack8(const f32x4 a, const f32x4 b) { v4u w; w.x = pk2(a.x, a.y); w.y = pk2(a.z, a.w); w.z = pk2(b.x, b.y); w.w = pk2(b.z, b.w); return __builtin_bit_cast(bf16x8_t, w); }

constexpr int GS_STRIDE = 264;
constexpr int SM_G_OFF = 0;
constexpr int SM_RED_OFF = 33792;
constexpr int SM_W_OFF = 36864, SM_W_BYTES = 8704;
static_assert(SM_W_OFF + 8 * SM_W_BYTES <= 131072, "ssm LDS");

__device__ __forceinline__ void rms_store_tile(Frame& F, const f32x4 (&o)[4][2], int base, int coff, int n0, int nmt) {
    const int c16 = F.lane & 15, g = F.lane >> 4;
    LAS float* red = (LAS float*)(F.lds + SM_RED_OFF);
#pragma unroll
    for (int mt = 0; mt < 4; ++mt) if (mt < nmt) {
        float ss = 0.f;
#pragma unroll
        for (int nt = 0; nt < 2; ++nt) ss += (o[mt][nt].x * o[mt][nt].x + o[mt][nt].y * o[mt][nt].y) + (o[mt][nt].z * o[mt][nt].z + o[mt][nt].w * o[mt][nt].w);
        ss += __shfl_xor(ss, 16); ss += __shfl_xor(ss, 32);
        if (g == 0) red[(mt * 16 + c16) * 8 + F.wave] = ss;
    }
    __syncthreads();
#pragma unroll
    for (int mt = 0; mt < 4; ++mt) if (mt < nmt) {
        const f32x4 a = *(const LAS f32x4*)(red + (mt * 16 + c16) * 8), b = *(const LAS f32x4*)(red + (mt * 16 + c16) * 8 + 4);
        const float rstd = rsqrtf((((a.x + a.y) + (a.z + a.w)) + ((b.x + b.y) + (b.z + b.w))) * (1.0f / 256.0f) + EPS);
        bf16* mp = (bf16*)(F.wl + WS_MIX) + (size_t)(base + mt * 16 + c16) * DM + coff + n0 + 4 * g;
#pragma unroll
        for (int nt = 0; nt < 2; ++nt) st_bf4(mp + 16 * nt, o[mt][nt] * rstd);
    }
}

__device__ __forceinline__ void ssm_unit(Frame& F, int L, int unit) {
    const kin_t IN = kin();
    const int lane = F.lane, c16 = lane & 15, g4 = lane >> 4;
    const float* tab = (const float*)(F.ws + WS_TAB) + (size_t)L * TAB_PER_L;
    const float* Us = (const float*)(F.wl + WS_US);
    const float* Hend = (const float*)(F.wl + WS_HEND);
    LAS bf16* Gs = (LAS bf16*)(F.lds + SM_G_OFF);
    LAS float* BUs = (LAS float*)(F.lds + SM_W_OFF + F.wave * SM_W_BYTES);
    LAS bf16* Hs = (LAS bf16*)BUs;
    const bool samp = unit >= 256; const int base = unit * 64, nsc = 4;
    const int b = unit >> 7, ci = unit & 127;
    for (int gg = 0; gg < 2; ++gg) {
        const int g = F.wave * 2 + gg;
        const float ar = tab[TAB_AB + (g * 2 + 0) * 64 + lane], ai = tab[TAB_AB + (g * 2 + 1) * 64 + lane];
        bf16x8_t bop[8];
#pragma unroll
        for (int nt = 0; nt < 8; ++nt) {
            const int ri = nt >> 2, p = (nt & 3) * 16 + c16;
            float t[8];
#pragma unroll
            for (int j = 0; j < 8; ++j) t[j] = (g4 < 2) ? tab[TAB_BB + (g * 32 + (8 * g4 + j) * 2 + ri) * 64 + p] : 0.f;
            bop[nt] = pack8((f32x4){t[0], t[1], t[2], t[3]}, (f32x4){t[4], t[5], t[6], t[7]});
        }
        bf16x8_t cop[4];
#pragma unroll
        for (int ks = 0; ks < 4; ++ks) {
            const int k0 = (32 * ks + 8 * g4) & 63; const bool im = ks >= 2;
            const float* cp = (im ? IN[16] : IN[15]) + ((size_t)(L * 16 + g) * 16 + c16) * 64 + k0;
            const f32x4 a = *(const GAS f32x4*)cp, c = *(const GAS f32x4*)(cp + 4);
            cop[ks] = im ? pack8(-a, -c) : pack8(a, c);
        }
        const float dsk = IN[17][L * 256 + g * 16 + c16];
        float hr = 0.f, hi = 0.f;
        if (!samp) {
            const float alr = tab[TAB_ABL + (g * 2 + 0) * 64 + lane], ali = tab[TAB_ABL + (g * 2 + 1) * 64 + lane];
            const float* he = Hend + ((size_t)(b * 128) * 16 + g) * 128 + lane;
            int j = 0;
            for (; j + 16 <= ci; j += 16) {
                float er[16], ei[16];
#pragma unroll
                for (int k = 0; k < 16; ++k) { er[k] = he[(size_t)(j + k) * 2048]; ei[k] = he[(size_t)(j + k) * 2048 + 64]; }
#pragma unroll
                for (int k = 0; k < 16; ++k) { const float nr = alr * hr - ali * hi + er[k], ni = alr * hi + ali * hr + ei[k]; hr = nr; hi = ni; }
            }
            for (; j < ci; ++j) { const float e0 = he[(size_t)j * 2048], e1 = he[(size_t)j * 2048 + 64]; const float nr = alr * hr - ali * hi + e0, ni = alr * hi + ali * hr + e1; hr = nr; hi = ni; }
        }
        bf16x8_t ua_n = (bf16x8_t){0, 0, 0, 0, 0, 0, 0, 0}; float usk_n[4];
        { if (g4 < 2) { const float* up = Us + (size_t)(base + c16) * 256 + g * 16 + 8 * g4; ua_n = pack8(*(const GAS f32x4*)up, *(const GAS f32x4*)(up + 4)); }
#pragma unroll
          for (int e = 0; e < 4; ++e) usk_n[e] = Us[(size_t)(base + 4 * g4 + e) * 256 + g * 16 + c16]; }
#pragma unroll 1
        for (int sc = 0; sc < nsc; ++sc) {
            const bf16x8_t ua = ua_n; float usk[4];
#pragma unroll
            for (int e = 0; e < 4; ++e) usk[e] = usk_n[e];
            if (sc + 1 < nsc) { const int r1 = base + (sc + 1) * 16;
                if (g4 < 2) { const float* up = Us + (size_t)(r1 + c16) * 256 + g * 16 + 8 * g4; ua_n = pack8(*(const GAS f32x4*)up, *(const GAS f32x4*)(up + 4)); }
#pragma unroll
                for (int e = 0; e < 4; ++e) usk_n[e] = Us[(size_t)(r1 + 4 * g4 + e) * 256 + g * 16 + c16]; }
#pragma unroll
            for (int nt = 0; nt < 8; ++nt) {
                const f32x4 d = MFMA16(ua, bop[nt], ((f32x4){0.f, 0.f, 0.f, 0.f}));
#pragma unroll
                for (int e = 0; e < 4; ++e) BUs[(4 * g4 + e) * 132 + nt * 16 + c16] = d[e];
            }
            float br[16], bi[16];
#pragma unroll
            for (int t = 0; t < 16; ++t) { br[t] = BUs[t * 132 + lane]; bi[t] = BUs[t * 132 + 64 + lane]; }
            asm volatile("s_waitcnt lgkmcnt(0)" ::: "memory");
#pragma unroll
            for (int t = 0; t < 16; ++t) {
                if (samp && (t & 7) == 0) { const int bs = (unit - 256) * 8 + sc * 2 + (t >> 3); hr = IN[4][((size_t)(L * 32 + bs) * 16 + g) * 64 + lane]; hi = IN[5][((size_t)(L * 32 + bs) * 16 + g) * 64 + lane]; }
                const float nhr = ar * hr - ai * hi + br[t], nhi = ar * hi + ai * hr + bi[t]; hr = nhr; hi = nhi;
                Hs[t * 136 + lane] = (bf16)f2bf(hr); Hs[t * 136 + 64 + lane] = (bf16)f2bf(hi);
                if (samp && (t & 7) == 7) { const int bs = (unit - 256) * 8 + sc * 2 + (t >> 3);
                    F.out[O_SRS + ((size_t)(L * 32 + bs) * 16 + g) * 64 + lane] = hr; F.out[O_SIS + ((size_t)(L * 32 + bs) * 16 + g) * 64 + lane] = hi; }
            }
            asm volatile("" ::: "memory");
            f32x4 y = (f32x4){0.f, 0.f, 0.f, 0.f};
#pragma unroll
            for (int ks = 0; ks < 4; ++ks) { const bf16x8_t ha = *(const LAS bf16x8_t*)(Hs + c16 * 136 + 32 * ks + 8 * g4); y = MFMA16(ha, cop[ks], y); }
#pragma unroll
            for (int e = 0; e < 4; ++e) Gs[(sc * 16 + 4 * g4 + e) * GS_STRIDE + g * 16 + c16] = (bf16)f2bf(gelu_tanh(y[e] + dsk * usk[e]));
            asm volatile("s_waitcnt lgkmcnt(0)" ::: "memory");
        }
        if (!samp && ci == 127) { F.out[O_SRP + ((size_t)(L * 2 + b) * 16 + g) * 64 + lane] = hr; F.out[O_SIP + ((size_t)(L * 2 + b) * 16 + g) * 64 + lane] = hi; }
    }
    __syncthreads();
    {
        const int n0 = 32 * F.wave;
        const bf16* Wt = (const bf16*)(F.ws + WS_WG) + (size_t)L * 65536;
        f32x4 acc[4][2];
#pragma unroll
        for (int mt = 0; mt < 4; ++mt) { acc[mt][0] = (f32x4){0.f, 0.f, 0.f, 0.f}; acc[mt][1] = acc[mt][0]; }
#pragma unroll
        for (int ks = 0; ks < 8; ++ks) {
            const bf16x8_t w0 = *(const GAS bf16x8_t*)(Wt + (size_t)(n0 + c16) * 256 + 32 * ks + 8 * g4), w1 = *(const GAS bf16x8_t*)(Wt + (size_t)(n0 + 16 + c16) * 256 + 32 * ks + 8 * g4);
#pragma unroll
            for (int mt = 0; mt < 4; ++mt) if (mt < nsc) {
                const bf16x8_t ga = *(const LAS bf16x8_t*)(Gs + (mt * 16 + c16) * GS_STRIDE + 32 * ks + 8 * g4);
                acc[mt][0] = MFMA16(w0, ga, acc[mt][0]); acc[mt][1] = MFMA16(w1, ga, acc[mt][1]);
            }
        }
        f32x4 o[4][2];
#pragma unroll
        for (int mt = 0; mt < 4; ++mt) { o[mt][0] = (f32x4){0.f, 0.f, 0.f, 0.f}; o[mt][1] = o[mt][0]; }
#pragma unroll
        for (int nt = 0; nt < 2; ++nt) {
            const f32x4 bias = *(const GAS f32x4*)(IN[19] + L * 256 + n0 + 16 * nt + 4 * g4);
#pragma unroll
            for (int mt = 0; mt < 4; ++mt) if (mt < nsc) {
                const v2u gw = *(const LAS v2u*)(Gs + (mt * 16 + c16) * GS_STRIDE + n0 + 16 * nt + 4 * g4);
                const f32x4 gv = (f32x4){bflo(gw.x), bfhi(gw.x), bflo(gw.y), bfhi(gw.y)};
                const f32x4 z = acc[mt][nt] + bias;
                o[mt][nt] = (f32x4){gv.x * sigmoidf_(z.x), gv.y * sigmoidf_(z.y), gv.z * sigmoidf_(z.z), gv.w * sigmoidf_(z.w)};
            }
        }
        rms_store_tile(F, o, base, 512, n0, nsc);
    }
    __syncthreads();
}

__device__ __forceinline__ void pool_unit(Frame& F, int L, int unit) {
    const kin_t IN = kin();
    const int lane = F.lane, c16 = lane & 15, g4 = lane >> 4;
    const float* Up = (const float*)(F.wl + WS_UPL);
    LAS bf16* Ps = (LAS bf16*)(F.lds + SM_G_OFF);
    const bool samp = unit >= 256; const int base = unit * 64, nsc = 4;
    {
        const int ch = F.tid & 255, half = F.tid >> 8, gi = ch >> 6;
        for (int q = 0; q < nsc; ++q) {
            const int lr0 = half * (nsc * 8) + q * 8, r0 = base + lr0;
            float v[23];
            int t0;
            if (!samp) { t0 = r0 & (SEQ - 1);
#pragma unroll
                for (int i = 0; i < 15; ++i) v[i] = (t0 - 15 + i >= 0) ? Up[(size_t)(r0 - 15 + i) * 256 + ch] : 0.f; }
            else { t0 = 0; const int bs = (r0 - MP) >> 3;
#pragma unroll
                for (int i = 0; i < 15; ++i) v[i] = IN[6][((size_t)(L * 32 + bs) * 15 + i) * 256 + ch]; }
#pragma unroll
            for (int i = 0; i < 8; ++i) v[15 + i] = Up[(size_t)(r0 + i) * 256 + ch];
            float cs[24]; cs[0] = 0.f;
#pragma unroll
            for (int i = 0; i < 23; ++i) cs[i + 1] = cs[i] + v[i];
            float r[8];
#pragma unroll
            for (int tau = 0; tau < 8; ++tau) {
                const float lo = gi == 0 ? cs[14 + tau] : (gi == 1 ? cs[12 + tau] : (gi == 2 ? cs[8 + tau] : cs[tau]));
                const int w = 2 << gi, t = t0 + tau; const float cnt = samp ? (float)w : (float)((t + 1 < w) ? t + 1 : w);
                r[tau] = (cs[16 + tau] - lo) / cnt - v[15 + tau];
            }
#pragma unroll
            for (int i = 0; i < 8; ++i) Ps[(lr0 + i) * GS_STRIDE + ch] = (bf16)f2bf(r[i]);
        }
    }
    __syncthreads();
    {
        const int gi = F.wave >> 1, d0 = 32 * (F.wave & 1), n0 = 64 * gi + d0;
        const bf16* Wt = (const bf16*)(F.ws + WS_PW) + (size_t)(L * 4 + gi) * 4096;
        f32x4 acc[4][2];
#pragma unroll
        for (int mt = 0; mt < 4; ++mt) { acc[mt][0] = (f32x4){0.f, 0.f, 0.f, 0.f}; acc[mt][1] = acc[mt][0]; }
#pragma unroll
        for (int ks = 0; ks < 2; ++ks) {
            const bf16x8_t w0 = *(const GAS bf16x8_t*)(Wt + (size_t)(d0 + c16) * 64 + 32 * ks + 8 * g4), w1 = *(const GAS bf16x8_t*)(Wt + (size_t)(d0 + 16 + c16) * 64 + 32 * ks + 8 * g4);
#pragma unroll
            for (int mt = 0; mt < 4; ++mt) if (mt < nsc) {
                const bf16x8_t pa = *(const LAS bf16x8_t*)(Ps + (mt * 16 + c16) * GS_STRIDE + 64 * gi + 32 * ks + 8 * g4);
                acc[mt][0] = MFMA16(w0, pa, acc[mt][0]); acc[mt][1] = MFMA16(w1, pa, acc[mt][1]);
            }
        }
        f32x4 o[4][2];
#pragma unroll
        for (int nt = 0; nt < 2; ++nt) {
            const f32x4 scl = *(const GAS f32x4*)(IN[21] + L * 256 + n0 + 16 * nt + 4 * g4);
#pragma unroll
            for (int mt = 0; mt < 4; ++mt) o[mt][nt] = acc[mt][nt] * scl;
        }
        rms_store_tile(F, o, base, 768, n0, nsc);
    }
    __syncthreads();
}

constexpr int AV_STRIDE = 160;
constexpr int AV_TILE = 32 * AV_STRIDE;
constexpr int AT_RED_OFF = 0, AT_V_OFF = 4096;
struct AStep { int sig, q, dmax, par, n0; };
__device__ __forceinline__ AStep astep(int s) {
    AStep a;
    if (s < 9) { a.sig = 8; a.q = 1; a.dmax = 256; a.par = 1; a.n0 = 16 - 32 * (9 - s); }
    else if (s < 14) { a.sig = 4; a.q = 2; a.dmax = 128; a.par = 0; a.n0 = 31 - 32 * (14 - s); }
    else { a.sig = 1; a.q = 8; a.dmax = 128; a.par = 0; a.n0 = 121 - 32 * (22 - s); }
    return a;
}
struct AFrag { bf16x8_t kA0, kA1, kB0, kB1; v4u v[4]; };
__device__ __forceinline__ void attn_load(AFrag& f, const bf16* Kh, const bf16* Vh, int RB, int tb  , const AStep& a, int lane) {
    const int c16 = lane & 15, g = lane >> 4;
    int pA = tb + a.sig * (a.n0 + c16), pB = pA + 16 * a.sig; pA = pA < 0 ? 0 : pA; pB = pB < 0 ? 0 : pB;
    const bf16* ka = Kh + (size_t)(RB + pA) * 512 + 8 * g; const bf16* kb = Kh + (size_t)(RB + pB) * 512 + 8 * g;
    f.kA0 = *(const GAS bf16x8_t*)ka; f.kA1 = *(const GAS bf16x8_t*)(ka + 32); f.kB0 = *(const GAS bf16x8_t*)kb; f.kB1 = *(const GAS bf16x8_t*)(kb + 32);
#pragma unroll
    for (int c = 0; c < 4; ++c) { int pv = tb + a.sig * (a.n0 + (lane >> 3) + 8 * c); pv = pv < 0 ? 0 : pv; f.v[c] = *(const GAS v4u*)(Vh + (size_t)(RB + pv) * 512 + 8 * (lane & 7)); }
}
__device__ __forceinline__ void attn_mfma_unit(Frame& F, int unit, int r0) {
    const int lane = F.lane, c16 = lane & 15, g = lane >> 4, h = F.wave;
    const int b = unit >> 6, T0 = (unit & 63) * 128, RB = b * SEQ;
    const bf16* Qh = (const bf16*)(F.wl + WS_QB) + h * 64; const bf16* Kh = (const bf16*)(F.wl + WS_KB) + h * 64; const bf16* Vh = (const bf16*)(F.wl + WS_VB) + h * 64;
    LAS unsigned char* vt = F.lds + AT_V_OFF + h * (2 * AV_TILE);
    LAS float* red = (LAS float*)(F.lds + AT_RED_OFF);
    const int vw_off = (lane >> 3) * AV_STRIDE + (lane & 7) * 16;
    const int vr_off = (4 * g + (c16 >> 2)) * AV_STRIDE + (c16 & 3) * 8;
    for (int r = r0; r < r0 + 1; ++r) {
        const int tb = T0 + r, qrow = RB + tb + 8 * c16;
        const bf16x8_t q0 = *(const GAS bf16x8_t*)(Qh + (size_t)qrow * 512 + 8 * g), q1 = *(const GAS bf16x8_t*)(Qh + (size_t)qrow * 512 + 32 + 8 * g);
        float m = -1e30f, l = 0.f;
        f32x4 acc[4];
#pragma unroll
        for (int d = 0; d < 4; ++d) acc[d] = (f32x4){0.f, 0.f, 0.f, 0.f};
        AFrag cur; attn_load(cur, Kh, Vh, RB, tb, astep(0), lane);
#pragma unroll
        for (int c = 0; c < 4; ++c) *(LAS v4u*)(vt + vw_off + c * 8 * AV_STRIDE) = cur.v[c];
        for (int s = 0; s < 22; ++s) {
            const AStep a = astep(s);
            AFrag nxt;
            if (s + 1 < 22) attn_load(nxt, Kh, Vh, RB, tb, astep(s + 1), lane);
            LAS unsigned char* vb = vt + (s & 1) * AV_TILE;
            f32x4 sA = (f32x4){0.f, 0.f, 0.f, 0.f}, sB = sA;
            sA = __builtin_amdgcn_mfma_f32_16x16x32_bf16(cur.kA0, q0, sA, 0, 0, 0); sA = __builtin_amdgcn_mfma_f32_16x16x32_bf16(cur.kA1, q1, sA, 0, 0, 0);
            sB = __builtin_amdgcn_mfma_f32_16x16x32_bf16(cur.kB0, q0, sB, 0, 0, 0); sB = __builtin_amdgcn_mfma_f32_16x16x32_bf16(cur.kB1, q1, sB, 0, 0, 0);
            const int hi = a.q * c16; int lo = hi - a.dmax;
            { const int nmin = -(tb / a.sig); lo = lo > nmin ? lo : nmin; }
            const int nb = a.n0 + 4 * g;
            float mx = -1e30f;
#pragma unroll
            for (int e = 0; e < 4; ++e) {
                const int nA = nb + e, nB = nA + 16;
                bool vA = nA >= lo && nA <= hi, vB = nB >= lo && nB <= hi;
                if (a.par) { const bool pe = ((nA ^ c16) & 1) == 0; vA = vA && pe; vB = vB && pe; }
                sA[e] = vA ? sA[e] : -1e30f; sB[e] = vB ? sB[e] : -1e30f;
                mx = fmaxf(mx, fmaxf(sA[e], sB[e]));
            }
            mx = fmaxf(mx, __shfl_xor(mx, 16)); mx = fmaxf(mx, __shfl_xor(mx, 32));
            const float mn = fmaxf(m, mx), scl = __builtin_amdgcn_exp2f(m - mn); m = mn;
            float ps = 0.f;
#pragma unroll
            for (int e = 0; e < 4; ++e) { sA[e] = __builtin_amdgcn_exp2f(sA[e] - mn); sB[e] = __builtin_amdgcn_exp2f(sB[e] - mn); ps += sA[e] + sB[e]; }
            l = l * scl + ps;
#pragma unroll
            for (int d = 0; d < 4; ++d) acc[d] = acc[d] * scl;
            v4u pw; pw.x = pk2(sA[0], sA[1]); pw.y = pk2(sA[2], sA[3]); pw.z = pk2(sB[0], sB[1]); pw.w = pk2(sB[2], sB[3]);
            const bf16x8_t pb = __builtin_bit_cast(bf16x8_t, pw);
#pragma unroll
            for (int d = 0; d < 4; ++d) {
                const s16x4_t v0 = __builtin_bit_cast(s16x4_t, __builtin_amdgcn_ds_read_tr16_b64_v4i16((LAS s16x4_t*)(vb + vr_off + d * 32)));
                const s16x4_t v1 = __builtin_bit_cast(s16x4_t, __builtin_amdgcn_ds_read_tr16_b64_v4i16((LAS s16x4_t*)(vb + vr_off + 16 * AV_STRIDE + d * 32)));
                const bf16x8_t vf = (bf16x8_t){v0[0], v0[1], v0[2], v0[3], v1[0], v1[1], v1[2], v1[3]};
                acc[d] = __builtin_amdgcn_mfma_f32_16x16x32_bf16(vf, pb, acc[d], 0, 0, 0);
            }
            if (s + 1 < 22) {
                LAS unsigned char* vn = vt + ((s + 1) & 1) * AV_TILE;
#pragma unroll
                for (int c = 0; c < 4; ++c) *(LAS v4u*)(vn + vw_off + c * 8 * AV_STRIDE) = nxt.v[c];
                cur = nxt;
            }
        }
        l += __shfl_xor(l, 16); l += __shfl_xor(l, 32);
        const float rl = 1.0f / l;
        float ss = 0.f;
#pragma unroll
        for (int d = 0; d < 4; ++d) { acc[d] = acc[d] * rl; ss += (acc[d].x * acc[d].x + acc[d].y * acc[d].y) + (acc[d].z * acc[d].z + acc[d].w * acc[d].w); }
        ss += __shfl_xor(ss, 16); ss += __shfl_xor(ss, 32);
        LAS float* rd = red + (r & 1) * 128 + c16 * 8;
        if (g == 0) rd[h] = ss;
        __syncthreads();
        float tot = 0.f;
#pragma unroll
        for (int w = 0; w < 8; ++w) tot += rd[w];
        const float rstd = rsqrtf(tot * (1.0f / 512.0f) + EPS);
        bf16* mp = (bf16*)(F.wl + WS_MIX) + (size_t)qrow * DM + h * 64 + 4 * g;
#pragma unroll
        for (int d = 0; d < 4; ++d) st_bf4(mp + 16 * d, acc[d] * rstd);
    }
    __syncthreads();
}

constexpr int U_PER = 256, U_SMP = 4;
__device__ __forceinline__ void mix_unit(Frame& F, int L, int type, int idx) {
    { int t_ = threadIdx.x; asm volatile("" : "+v"(t_)); F.tid = t_; F.lane = t_ & 63; F.wave = __builtin_amdgcn_readfirstlane(t_ >> 6);
      const kin_t ka = kin(); F.out = (float*)ka[32]; F.ws = (unsigned char*)ka[33]; F.wl = layer_base(F.ws, L); }
    const int xl = idx & 7, xj = idx >> 3;
    if (type == 0) {
        const bool heavy = idx < 8 && !(idx & 1);
        const int nt = heavy ? 1 : 4;
        for (int k = 0; k < nt; ++k) attn_mfma_unit(F, 16 * xl + (xj >> 1), 4 * (xj & 1) + k);
        if (idx >= 8 && idx < 20) { const int hx = idx - 8, src = 2 * (hx / 3), k = 1 + hx % 3;
            attn_mfma_unit(F, 16 * src, k); }
    }
    else if (type == 1) {
        float o[16];
        const int sr = (4 * xl + (xj >> 3)) * 8 + (xj & 7);
        attn_row<true>(F, L, MP + sr, sr >> 3, sr & 7, F.wave, o);
        attn_store(F, MP + sr, F.wave, o, 0);
        __syncthreads();
    } else if (type == 2) ssm_unit(F, L, idx);
    else pool_unit(F, L, idx);
}
__device__ __forceinline__ void ph_mix(Frame& F, int L, int ptype, int pn) {
    for (int c = F.bx; c < U_PER; c += F.G) {
        for (int i = 0; i < 4; ++i) {
            const int type = i, reps = (type == ptype) ? pn : 1;
            if (type == 3 && c >= 8 && c < 20) continue;
            for (int rep = 0; rep < reps; ++rep) mix_unit(F, L, type, c);
        }
        if (c >= 20 && c < 32) mix_unit(F, L, 3, c - 12);
    }
    for (int e = F.bx; e < 2 * U_SMP; e += F.G) {
        const int type = 2 + (e & 1), reps = (type == ptype) ? pn : 1;
        for (int rep = 0; rep < reps; ++rep) mix_unit(F, L, type, 256 + (e >> 1));
    }
}

__device__ __forceinline__ void ph_convfix(Frame& F, int L) {
    const kin_t IN = kin();
    const float* halo = (const float*)(F.wl + WS_HALO); bf16* Act = (bf16*)(F.wl + WS_ACT);
    const float* cw = IN[28] + (size_t)L * 3 * DUP; const float* cb = IN[29] + (size_t)L * DUP;
    constexpr int CQ = DFF / 4, NIT = 256 * 2 * CQ;
    for (int it = F.bx * 512 + F.tid; it < NIT; it += F.G * 512) {
        const int c0 = (it % CQ) * 4, hr = (it / CQ) & 1, seg = it / (2 * CQ);
        const int pc = 256 * (c0 / 128) + (c0 % 128);
        const bool first = (seg & 127) == 0;
        const f32x4 z = (f32x4){0.f, 0.f, 0.f, 0.f};
        const float* hc = halo + (size_t)seg * 4 * DUP; const float* hp = hc - 4 * DUP;
        const f32x4 xa = *(const GAS f32x4*)(hc + hr * DUP + pc), xg = *(const GAS f32x4*)(hc + hr * DUP + pc + 128);
        f32x4 a1, g1, a2, g2;
        if (hr == 0) { a1 = first ? z : *(const GAS f32x4*)(hp + 3 * DUP + pc); g1 = first ? z : *(const GAS f32x4*)(hp + 3 * DUP + pc + 128);
                       a2 = first ? z : *(const GAS f32x4*)(hp + 2 * DUP + pc); g2 = first ? z : *(const GAS f32x4*)(hp + 2 * DUP + pc + 128); }
        else { a1 = *(const GAS f32x4*)(hc + pc); g1 = *(const GAS f32x4*)(hc + pc + 128);
               a2 = first ? z : *(const GAS f32x4*)(hp + 3 * DUP + pc); g2 = first ? z : *(const GAS f32x4*)(hp + 3 * DUP + pc + 128); }
        const int ca = c0, cg = DFF + c0;
        const f32x4 av = *(const GAS f32x4*)(cb + ca) + a2 * *(const GAS f32x4*)(cw + ca) + a1 * *(const GAS f32x4*)(cw + DUP + ca) + xa * *(const GAS f32x4*)(cw + 2 * DUP + ca);
        const f32x4 gv = *(const GAS f32x4*)(cb + cg) + g2 * *(const GAS f32x4*)(cw + cg) + g1 * *(const GAS f32x4*)(cw + DUP + cg) + xg * *(const GAS f32x4*)(cw + 2 * DUP + cg);
        st_bf4(Act + (size_t)(seg * 64 + hr) * DFF + c0, silu_gate4(gv, av));
    }
}


constexpr int SG_STRIDE = 68;
template <int MODE>
__device__ __forceinline__ void sgemm_sample(Frame& F, int L, const bf16* A  , const bf16* Bt  , int N, int K,
                                             const float* xs  , int xin_off, int xf_off, int xb_off, int rs_off  ) {
    const int lane = F.lane, c16 = lane & 15, g4 = lane >> 4;
    LAS float* part = (LAS float*)F.lds;
    const int ntile = 8 * (N / 64), kw = K / 8, ksteps = kw / 32, k0 = F.wave * kw;
    for (int tile = F.bx; tile < ntile; tile += F.G) {
        const int tm = tile & 7, tn = tile >> 3;
        f32x4 acc[2][4];
#pragma unroll
        for (int mi = 0; mi < 2; ++mi)
#pragma unroll
            for (int ni = 0; ni < 4; ++ni) acc[mi][ni] = (f32x4){0.f, 0.f, 0.f, 0.f};
        const bf16* ap = A + (size_t)(tm * 32 + c16) * K + k0 + 8 * g4;
        const bf16* bp = Bt + (size_t)(tn * 64 + c16) * K + k0 + 8 * g4;
#pragma unroll 4
        for (int ks = 0; ks < ksteps; ++ks) {
            bf16x8_t a[2], b[4];
#pragma unroll
            for (int mi = 0; mi < 2; ++mi) a[mi] = *(const GAS bf16x8_t*)(ap + (size_t)(mi * 16) * K + ks * 32);
#pragma unroll
            for (int ni = 0; ni < 4; ++ni) b[ni] = *(const GAS bf16x8_t*)(bp + (size_t)(ni * 16) * K + ks * 32);
#pragma unroll
            for (int mi = 0; mi < 2; ++mi)
#pragma unroll
                for (int ni = 0; ni < 4; ++ni) acc[mi][ni] = MFMA16(b[ni], a[mi], acc[mi][ni]);
        }
#pragma unroll
        for (int mi = 0; mi < 2; ++mi)
#pragma unroll
            for (int ni = 0; ni < 4; ++ni) *(LAS f32x4*)(part + (F.wave * 32 + mi * 16 + c16) * SG_STRIDE + ni * 16 + 4 * g4) = acc[mi][ni];
        __syncthreads();
        {
            const int r = F.tid >> 4, c4 = (F.tid & 15) * 4;
            f32x4 v = *(const LAS f32x4*)(part + r * SG_STRIDE + c4);
#pragma unroll
            for (int w = 1; w < 8; ++w) v = v + *(const LAS f32x4*)(part + (w * 32 + r) * SG_STRIDE + c4);
            const int row = MP + tm * 32 + r, col = tn * 64 + c4;
            if (MODE == 0) {
                const Epi1Ptrs P = epi1_ptrs(F.ws, F.out, L);
                const float rstd = rstd_from_partials(P.rs, row, 1.0f / 1024.0f);
                epi1_store(P, row, col >> 8, col & 255, v * rstd);
            } else {
                const float* Xin = (const float*)(F.ws + xin_off); float* Xf = (float*)(F.ws + xf_off); bf16* Xb = (bf16*)(F.ws + xb_off); float* rso = (float*)(F.ws + rs_off);
                const float* brow = xs ? xs + (size_t)(row - MP) * DM : Xin + (size_t)row * DM;
                v = v + *(const GAS f32x4*)(brow + col);
                *(GAS f32x4*)(Xf + (size_t)row * DM + col) = v;
                st_bf4(Xb + (size_t)row * DM + col, v);
                float ss = (v.x * v.x + v.y * v.y) + (v.z * v.z + v.w * v.w);
                ss += __shfl_xor(ss, 1); ss += __shfl_xor(ss, 2); ss += __shfl_xor(ss, 4); ss += __shfl_xor(ss, 8);
                if ((F.tid & 15) == 0) rso[(size_t)tn * MT + row] = ss;
            }
        }
        __syncthreads();
    }
}


__device__ __forceinline__ void l2_sweep(Frame& F, int which) {
    const kin_t INx = kin(); const GAS f32x4* src = (const GAS f32x4*)INx[2] + (size_t)which * (256 * 16384) + (size_t)F.bx * 16384 + F.tid;
    f32x4 s = (f32x4){0.f, 0.f, 0.f, 0.f};
#pragma unroll 8
    for (int i = 0; i < 32; ++i) s = s + src[(size_t)i * 512];
    if (s.x + s.y + s.z + s.w == 12345.678f) F.out[0] = s.x;
}

__device__ __forceinline__ void ph_final(Frame& F) {
    const kin_t IN = kin();
    const float* Xf = (const float*)(F.ws + WS_XFV0 + 3 * XF_VSTRIDE); const float* rs1 = (const float*)(F.ws + WS_RS1V0 + 2 * RS_VSTRIDE); const float* gf = IN[31];
    const int gw = F.bx * 8 + F.wave, NGW = F.G * 8;
    for (int m = gw; m < MT; m += NGW) {
        const float rstd = rstd_from_partials(rs1, m, 1.0f / 1024.0f);
        const GAS f32x4* xr = (const GAS f32x4*)(Xf + (size_t)m * DM) + F.lane; const GAS f32x4* gr = (const GAS f32x4*)gf + F.lane;
        GAS f32x4* orow = (GAS f32x4*)(F.out + (m < MP ? O_YP + (size_t)m * DM : O_YS + (size_t)(m - MP) * DM)) + F.lane;
#pragma unroll
        for (int j = 0; j < 4; ++j) orow[64 * j] = xr[64 * j] * rstd * gr[64 * j];
    }
}

namespace cg = cooperative_groups;
constexpr int LDSCTL_OFF = 131072, MISC_OFF = LDSCTL_OFF + 320;
constexpr int CW_BAR = 4096;
constexpr int N_PHASES = 16;
__global__ void __launch_bounds__(512, 2) fwd_kernel(Args args) {
    extern __shared__ __attribute__((aligned(16))) unsigned char lds[];
    Frame F;
    F.lds = (LAS unsigned char*)lds; F.G = gridDim.x;
    for (int u = threadIdx.x; u < (LDS_BYTES - LDSCTL_OFF) / 4; u += 512) ((LAS unsigned*)(F.lds + LDSCTL_OFF))[u] = 0u;
    __syncthreads();
    const bool fused = (args.ph_hi - args.ph_lo) > 1;
    XcdBarrier bar; bar.bar = (unsigned*)(args.ws + WS_CTL) + CW_BAR; bar.x = 0; bar.st = nullptr;
    if (fused) bar = xcd_barrier_post((unsigned*)(args.ws + WS_CTL) + CW_BAR, (volatile LAS unsigned*)(F.lds + MISC_OFF) + 8);
    for (int ph = args.ph_lo; ph < args.ph_hi; ++ph) {
#ifndef PHM
#define PHM 0xFFFF
#endif
        const int L = (ph - 1) / 7, sub = (ph == 0 || ph == 15) ? -1 : (ph - 1) % 7;
        const int nrep = (args.probe_n > 1 && (sub == args.probe_sub || (ph == 0 && args.probe_sub == 7) || (ph == 15 && args.probe_sub == 8))) ? args.probe_n : 1;
        for (int rep = 0; rep < nrep; ++rep) {
        {
            int t_ = threadIdx.x; asm volatile("" : "+v"(t_));
            F.tid = t_; F.lane = t_ & 63; F.wave = __builtin_amdgcn_readfirstlane(t_ >> 6);
            int bx_ = blockIdx.x; asm volatile("" : "+s"(bx_)); F.bx = bx_;
            const kin_t ka = kin(); F.out = (float*)ka[32]; F.ws = (unsigned char*)ka[33];
        }
        unsigned char* ws = F.ws;
        F.wl = layer_base(ws, L < 0 ? 0 : (L > 1 ? 1 : L)); unsigned char* wl = F.wl;
        if (ph == 0) { ph_prologue(F); l2_sweep(F, 0); }
        else if (ph == 15) { ph_final(F); }
        else if (sub == 0) {
            const bf16* Xin = (const bf16*)(ws + WS_XBV0 + (size_t)(2 * L) * XB_VSTRIDE);
            pg8::Gemm g{Xin, (const bf16*)(ws + WS_WIN) + (size_t)L * DIN * DM, MP, DIN, DM}; pg8::StaticOrder S; S.init(MP, DIN, F.G, F.bx);
            Epi1 E{ws, F.out, L};
            pg8::gemm_phase<Epi1, pg8::StaticOrder, true, true>(F.lds, g, S, E);
            sgemm_sample<0>(F, L, Xin + (size_t)MP * DM, (const bf16*)(ws + WS_WIN) + (size_t)L * DIN * DM, DIN, DM, nullptr, 0, 0, 0, 0);
        } else if (sub == 1) { ph_ssm1(F, L); }
        else if (sub == 2) { ph_mix(F, L, args.probe_sub - 10, args.probe_n); }
        else if (sub == 3) {
            const kin_t IN = kin();
            const int xin = (int)(WS_XFV0 + 1 * XF_VSTRIDE), xf = (int)(WS_XFV0 + (size_t)(2 * L) * XF_VSTRIDE), xb = (int)(WS_XBV0 + (size_t)(1 + 2 * L) * XB_VSTRIDE), rs = (int)(WS_LAYER0 + (size_t)L * LSTRIDE + WS_RS2);
            pg8::Gemm g{(const bf16*)(wl + WS_MIX), (const bf16*)(ws + WS_WOUT) + (size_t)L * DM * DM, MP, DM, DM}; pg8::StaticOrder S; S.init(MP, DM, F.G, F.bx);
            EpiRes E{ws, L == 0 ? IN[0] : nullptr, L == 0 ? IN[1] : nullptr, xin, xf, xb, rs};
            pg8::gemm_phase<EpiRes, pg8::StaticOrder, true, true>(F.lds, g, S, E);
            sgemm_sample<1>(F, L, (const bf16*)(wl + WS_MIX) + (size_t)MP * DM, (const bf16*)(ws + WS_WOUT) + (size_t)L * DM * DM, DM, DM, L == 0 ? IN[1] : nullptr, xin, xf, xb, rs);
        } else if (sub == 6) {
            const int xin = (int)(WS_XFV0 + (size_t)(2 * L) * XF_VSTRIDE), xf = (int)(WS_XFV0 + (size_t)(2 * L + 1) * XF_VSTRIDE), xb = (int)(WS_XBV0 + (size_t)(2 + 2 * L) * XB_VSTRIDE), rs = (int)(WS_RS1V0 + (size_t)(1 + L) * RS_VSTRIDE);
            pg8::Gemm g{(const bf16*)(wl + WS_ACT), (const bf16*)(ws + WS_WDN) + (size_t)L * DM * DFF, MP, DM, DFF}; pg8::StaticOrder S; S.init(MP, DM, F.G, F.bx);
            EpiRes E{ws, nullptr, nullptr, xin, xf, xb, rs};
            pg8::gemm_phase<EpiRes, pg8::StaticOrder, true, true>(F.lds, g, S, E);
            sgemm_sample<1>(F, L, (const bf16*)(wl + WS_ACT) + (size_t)MP * DFF, (const bf16*)(ws + WS_WDN) + (size_t)L * DM * DFF, DM, DFF, nullptr, xin, xf, xb, rs);
            if (L == 0) l2_sweep(F, 1);
        } else if (sub == 4) {
            const bf16* Xin = (const bf16*)(ws + WS_XBV0 + (size_t)(1 + 2 * L) * XB_VSTRIDE);
            pg8::Gemm g{Xin, (const bf16*)(ws + WS_WUP) + (size_t)L * DUP * DM, MT, DUP, DM}; pg8::StaticOrder S; S.init(MT, DUP, F.G, F.bx);
            const kin_t IN = kin();
            Epi3 E{ws, F.out, L, IN[28] + (size_t)L * 3 * DUP, IN[29] + (size_t)L * DUP, IN[7] + (size_t)L * 32 * 2 * DUP};
            pg8::gemm_phase<Epi3, pg8::StaticOrder, true, true>(F.lds, g, S, E);
        } else if (sub == 5) { ph_convfix(F, L); }
        if (rep + 1 < nrep) __syncthreads();
        }
        if (ph + 1 < args.ph_hi) {
            if (ph == 0) cg::this_grid().sync(); else xcd_barrier(bar);
        }
    }
}

#ifndef PROBE_SUB
#define PROBE_SUB 0
#define PROBE_N 1
#endif
#ifndef N_LAUNCHES
#define N_LAUNCHES 1
#endif
extern "C" void kernel_launch(void* const* d_in, const int* in_sizes, int n_in, void* d_out, int out_size, void* d_ws, size_t ws_size, hipStream_t stream) {
    static int grid = 0;
    if (grid == 0) {
        if (n_in != 32 || out_size != (int)O_END || ws_size < WS_END) { fprintf(stderr, "kernel_launch: unexpected shapes (n_in %d out %d ws %zu)\n", n_in, out_size, ws_size); grid = -1; return; }
        int dev = 0, cus = 0, per_cu = 0;
        if (hipGetDevice(&dev) != hipSuccess || hipDeviceGetAttribute(&cus, hipDeviceAttributeMultiprocessorCount, dev) != hipSuccess) { grid = -1; return; }
        if (hipFuncSetAttribute((const void*)fwd_kernel, hipFuncAttributeMaxDynamicSharedMemorySize, LDS_BYTES) != hipSuccess) { fprintf(stderr, "hipFuncSetAttribute failed\n"); grid = -1; return; }
        if (hipOccupancyMaxActiveBlocksPerMultiprocessor(&per_cu, (const void*)fwd_kernel, 512, LDS_BYTES) != hipSuccess || per_cu < 1) { fprintf(stderr, "occupancy query failed (%d)\n", per_cu); (void)hipGetLastError(); grid = -1; return; }
        grid = cus;
    }
    if (grid < 0) return;
    Args a{};
    for (int i = 0; i < 32; ++i) a.in[i] = (const float*)d_in[i];
    a.out = (float*)d_out; a.ws = (unsigned char*)d_ws; a.probe_sub = PROBE_SUB; a.probe_n = PROBE_N;
    if (N_LAUNCHES == 1) {
        if (hipMemsetAsync((char*)d_ws + WS_CTL, 0, CTL_ZERO_BYTES, stream) != hipSuccess) { fprintf(stderr, "memset failed\n"); return; }
        a.ph_lo = 0; a.ph_hi = N_PHASES;
        void* kargs[] = {&a};
        const hipError_t e = hipLaunchCooperativeKernel((const void*)fwd_kernel, dim3(grid), dim3(512), kargs, LDS_BYTES, stream);
        if (e != hipSuccess) fprintf(stderr, "cooperative launch failed: %s (grid %d)\n", hipGetErrorString(e), grid);
    } else {
        for (int ph = 0; ph < N_PHASES; ++ph) {
            a.ph_lo = ph; a.ph_hi = ph + 1;
            hipLaunchKernelGGL(fwd_kernel, dim3(grid), dim3(512), LDS_BYTES, stream, a);
        }
    }
}
```
